# Optimizing an MI355X kernel written in HIP

```python
import jax, jax.numpy as jnp
from jax import lax
import numpy as np

D_MODEL = 1024
BATCH = 8
SEQ = 2048
DEPTH = 2
DEC_BATCH = 128
DEC_SEQ = 4
PAST_LEN = 16384
PAGE_SIZE = 128

N_MIXERS = 2
N_CONV_LAYERS = (DEPTH + 1) // 2
N_RET_LAYERS = DEPTH // 2
CONV_WIDTH = 3
N_HEADS = 4
QK_DIM = D_MODEL
HEAD_DK = QK_DIM // N_HEADS
V_DIM = 2 * D_MODEL
HEAD_DV = V_DIM // N_HEADS
RET_IN = 2 * QK_DIM + 2 * V_DIM
CHUNK = 128
D_FF = -(-8 * D_MODEL // (3 * 256)) * 256
RMS_EPS = 1e-6
GN_EPS = 1e-6
ROPE_BASE = 10000.0

kernel_name = "hybrid_shortconv_retention_decode_step"


def rmsnorm(x, g):
    xf = x.astype(jnp.float32)
    y = xf * lax.rsqrt(jnp.mean(xf * xf, axis=-1, keepdims=True) + RMS_EPS)
    return (y * g.astype(jnp.float32)).astype(x.dtype)


def swiglu(x, w_gate, w_up, w_down):
    return (jax.nn.silu(x @ w_gate) * (x @ w_up)) @ w_down


def short_conv_mixer(x, buf, w_in, w_conv, w_out):
    L = x.shape[1]
    b, c, h = jnp.split(x @ w_in, 3, axis=-1)
    u = c * h
    full = jnp.concatenate([buf.astype(u.dtype), u], axis=1)
    y = sum(w_conv[j] * full[:, j:j + L] for j in range(CONV_WIDTH))
    out = (b * y) @ w_out
    return out, full[:, -(CONV_WIDTH - 1):]


def rotary(x, pos):
    half = x.shape[-1] // 2
    inv = ROPE_BASE ** (-jnp.arange(half, dtype=jnp.float32) / half)
    ang = pos.astype(jnp.float32)[:, None] * inv[None, :]
    cos, sin = jnp.cos(ang), jnp.sin(ang)
    xf = x.astype(jnp.float32)
    x1, x2 = xf[..., :half], xf[..., half:]
    return jnp.concatenate([x1 * cos - x2 * sin, x1 * sin + x2 * cos], axis=-1).astype(x.dtype)


def retention_chunkwise(q, k, v, s0):
    B, H, L, _ = q.shape
    C = L if L <= CHUNK else CHUNK
    n = L // C
    dt = q.dtype
    log_g = jnp.log(1.0 - 2.0 ** (-5.0 - jnp.arange(H, dtype=jnp.float32)))
    idx = jnp.arange(C, dtype=jnp.float32)
    diff = idx[:, None] - idx[None, :]
    decay = jnp.where(diff[None] >= 0, jnp.exp(jnp.maximum(diff, 0.0)[None] * log_g[:, None, None]), 0.0).astype(dt)
    cross_w = jnp.exp((idx[None] + 1.0) * log_g[:, None]).astype(dt)
    state_w = jnp.exp((C - 1.0 - idx[None]) * log_g[:, None]).astype(dt)
    chunk_decay = jnp.exp(C * log_g).astype(dt)

    def to_chunks(t):
        return jnp.moveaxis(t.reshape(B, H, n, C, t.shape[-1]), 2, 0)

    def step(S, qkv):
        qc, kc, vc = qkv
        scores = jnp.einsum('bhid,bhjd->bhij', qc, kc) * decay
        inner = jnp.einsum('bhij,bhjv->bhiv', scores, vc)
        cross = jnp.einsum('bhid,bhdv->bhiv', qc, S) * cross_w[:, :, None]
        S_new = S * chunk_decay[:, None, None] + jnp.einsum('bhjd,bhjv->bhdv', kc * state_w[:, :, None], vc)
        return S_new, inner + cross

    S, o = lax.scan(step, s0.astype(dt), (to_chunks(q), to_chunks(k), to_chunks(v)))
    o = jnp.moveaxis(o, 0, 2).reshape(B, H, L, v.shape[-1])
    return o, S


def retention_mixer(x, s0, pos, w_in, gn_g, w_out):
    B, L, _ = x.shape
    z = x @ w_in
    q, k, v, g = jnp.split(z, [QK_DIM, 2 * QK_DIM, 2 * QK_DIM + V_DIM], axis=-1)
    q = q.reshape(B, L, N_HEADS, HEAD_DK).transpose(0, 2, 1, 3)
    k = k.reshape(B, L, N_HEADS, HEAD_DK).transpose(0, 2, 1, 3)
    v = v.reshape(B, L, N_HEADS, HEAD_DV).transpose(0, 2, 1, 3)
    q = rotary(q, pos)
    k = rotary(k, pos) * (HEAD_DK ** -0.5)
    o, S = retention_chunkwise(q, k, v, s0)
    of = o.astype(jnp.float32)
    mu = jnp.mean(of, axis=-1, keepdims=True)
    var = jnp.mean(jnp.square(of - mu), axis=-1, keepdims=True)
    of = (of - mu) * lax.rsqrt(var + GN_EPS)
    of = of.transpose(0, 2, 1, 3).reshape(B, L, V_DIM) * gn_g.astype(jnp.float32)
    out = (jax.nn.silu(g) * of.astype(x.dtype)) @ w_out
    return out, S


def trunk(x, conv_bufs, ret_states, pos, norm_mix, norm_ffn, conv_w_in, conv_w, conv_w_out,
          ret_w_in, ret_gn, ret_w_out, ffn_w_gate, ffn_w_up, ffn_w_down, final_norm):
    new_conv, new_ret = [], []
    for i in range(DEPTH):
        j = i // N_MIXERS
        h = rmsnorm(x, norm_mix[i])
        if i % N_MIXERS == 0:
            m, st = short_conv_mixer(h, conv_bufs[j], conv_w_in[j], conv_w[j], conv_w_out[j])
            new_conv.append(st)
        else:
            m, st = retention_mixer(h, ret_states[j], pos, ret_w_in[j], ret_gn[j], ret_w_out[j])
            new_ret.append(st)
        x = x + m
        x = x + swiglu(rmsnorm(x, norm_ffn[i]), ffn_w_gate[i], ffn_w_up[i], ffn_w_down[i])
    return rmsnorm(x, final_norm), jnp.stack(new_conv), jnp.stack(new_ret)


def setup_inputs(seed: int = 0) -> dict:
    key = jax.random.key(seed)
    ks = jax.random.split(key, 16)
    nrm = jax.random.normal
    D = D_MODEL
    return {
        "x_prompt": nrm(ks[0], (BATCH, SEQ, D), jnp.float32),
        "x_sample": nrm(ks[1], (DEC_BATCH, DEC_SEQ, D), jnp.float32),
        "state_conv": nrm(ks[2], (N_CONV_LAYERS, DEC_BATCH, CONV_WIDTH - 1, D), jnp.float32),
        "state_ret": 0.5 * nrm(ks[3], (N_RET_LAYERS, DEC_BATCH, N_HEADS, HEAD_DK, HEAD_DV), jnp.float32),
        "norm_mix": 1.0 + 0.02 * nrm(ks[4], (DEPTH, D), jnp.float32),
        "norm_ffn": 1.0 + 0.02 * nrm(ks[5], (DEPTH, D), jnp.float32),
        "conv_w_in": nrm(ks[6], (N_CONV_LAYERS, D, 3 * D), jnp.float32) * D ** -0.5,
        "conv_w": nrm(ks[7], (N_CONV_LAYERS, CONV_WIDTH, D), jnp.float32) * CONV_WIDTH ** -0.5,
        "conv_w_out": nrm(ks[8], (N_CONV_LAYERS, D, D), jnp.float32) * D ** -0.5,
        "ret_w_in": nrm(ks[9], (N_RET_LAYERS, D, RET_IN), jnp.float32) * D ** -0.5,
        "ret_gn": 1.0 + 0.02 * nrm(ks[10], (N_RET_LAYERS, V_DIM), jnp.float32),
        "ret_w_out": nrm(ks[11], (N_RET_LAYERS, V_DIM, D), jnp.float32) * V_DIM ** -0.5,
        "ffn_w_gate": nrm(ks[12], (DEPTH, D, D_FF), jnp.float32) * D ** -0.5,
        "ffn_w_up": nrm(ks[13], (DEPTH, D, D_FF), jnp.float32) * D ** -0.5,
        "ffn_w_down": nrm(ks[14], (DEPTH, D_FF, D), jnp.float32) * D_FF ** -0.5,
        "final_norm": 1.0 + 0.02 * nrm(ks[15], (D,), jnp.float32),
    }


def reference(x_prompt, x_sample, state_conv, state_ret, norm_mix, norm_ffn, conv_w_in, conv_w,
              conv_w_out, ret_w_in, ret_gn, ret_w_out, ffn_w_gate, ffn_w_up, ffn_w_down, final_norm):
    Bp, Lp, _ = x_prompt.shape
    Ls = x_sample.shape[1]
    conv0 = jnp.zeros((N_CONV_LAYERS, Bp, CONV_WIDTH - 1, D_MODEL), x_prompt.dtype)
    ret0 = jnp.zeros((N_RET_LAYERS, Bp, N_HEADS, HEAD_DK, HEAD_DV), x_prompt.dtype)
    pos_p = jnp.arange(Lp, dtype=jnp.float32)
    pos_s = PAST_LEN + jnp.arange(Ls, dtype=jnp.float32)
    w = (norm_mix, norm_ffn, conv_w_in, conv_w, conv_w_out, ret_w_in, ret_gn, ret_w_out,
         ffn_w_gate, ffn_w_up, ffn_w_down, final_norm)
    y_prompt, conv_prompt, ret_prompt = trunk(x_prompt, conv0, ret0, pos_p, *w)
    y_sample, conv_sample, ret_sample = trunk(x_sample, state_conv, state_ret, pos_s, *w)
    return (y_prompt, y_sample, conv_prompt, conv_sample, ret_prompt, ret_sample)
```

```cpp
#include <hip/hip_runtime.h>
#include <hip/hip_cooperative_groups.h>
#include <cstdio>
#include <cstdint>
namespace cg = cooperative_groups;

#ifndef MK_N_LAUNCHES
#define MK_N_LAUNCHES 1
#endif

namespace pg8 {
#define PG8_LAS __attribute__((address_space(3)))
typedef unsigned short bf16_t;
typedef short bf16x8 __attribute__((ext_vector_type(8)));
typedef float f32x4 __attribute__((ext_vector_type(4)));
typedef unsigned u32x4 __attribute__((ext_vector_type(4)));
constexpr int BM = 256, BK = 64, HALF = 128, HTB = HALF * BK * 2, STAGE_BYTES = 8 * HTB, NXCD = 8, WGM = 8;

__host__ __device__ __forceinline__ int lds_byte(int r, int c) { const int st = (r >> 4) * 2 + (c >> 5), rr = r & 15, cc = c & 31, ob = rr * 64 + cc * 2; return st * 1024 + (ob ^ (((ob >> 9) & 1) << 5)); }
__host__ __device__ __forceinline__ void stage_rc(int b, int& R, int& C) { const int st = b / 1024, sb = b % 1024, swz = sb ^ (((sb >> 9) & 1) << 5); R = (st >> 1) * 16 + swz / 64; C = (st & 1) * 32 + (swz % 64) / 2; }
__host__ __device__ __forceinline__ int perm32(int rho) { const int n = rho >> 4, i = rho & 15; return 8 * (i >> 2) + 4 * n + (i & 3); }

struct Unit { int pm, pn, kt0, nt; };
struct Gemm { const bf16_t* A; const bf16_t* Bt; int M, N, K; };

struct StaticOrder {
    int nM, nN, nwg, G, c, ntk;
    __host__ __device__ void init(int M, int N, int G_, int c_, int K) { nM = M / BM; nN = N / BM; nwg = nM * nN; G = G_; c = c_; ntk = K / BK; }
    __host__ __device__ bool next(int i, Unit& u) const {
        const long L = (long)i * G + c; if (L >= nwg) return false;
        int wgid = (int)L; { const int q = nwg / NXCD, r = nwg % NXCD, xcd = wgid % NXCD, off = wgid / NXCD; wgid = (xcd < r ? xcd * (q + 1) : r * (q + 1) + (xcd - r) * q) + off; }
        const int nig = WGM * nN, gid = wgid / nig, fm = gid * WGM, gsz = (nM - fm) < WGM ? (nM - fm) : WGM;
        u.pm = fm + ((wgid % nig) % gsz); u.pn = (wgid % nig) / gsz; u.kt0 = 0; u.nt = ntk; return true;
    }
    __device__ __forceinline__ void a_ready(const Unit&) const {}
    __device__ __forceinline__ void done(const Unit&) const {}
};
struct SplitOrder {
    StaticOrder P; int nslice, G, c;
    __host__ __device__ void init(int Mp, int N, int G_, int c_, int K) { P.init(Mp, N, G_, c_, K); nslice = (K / BK) / 4; G = G_; c = c_; }
    __host__ __device__ bool next(int i, Unit& u) const {
        const long L = (long)i * G + c;
        if (L < P.nwg) return P.next(i, u);
        const int j = (int)(L - P.nwg), nS = 2 * P.nN;
        if (j >= nS * nslice) return false;
        const int su = j % nS, sl = j / nS;
        u.pm = P.nM + su / P.nN; u.pn = su % P.nN; u.kt0 = sl * 4; u.nt = 4; return true;
    }
    __device__ __forceinline__ void a_ready(const Unit&) const {}
    __device__ __forceinline__ void done(const Unit&) const {}
};
typedef __bf16 bf16x2_cv __attribute__((ext_vector_type(2)));
typedef float f32x2_cv __attribute__((ext_vector_type(2)));
__device__ __forceinline__ unsigned cvt_pk_bf16(float lo, float hi) { const bf16x2_cv v = __builtin_convertvector((f32x2_cv){lo, hi}, bf16x2_cv); return __builtin_bit_cast(unsigned, v); }

template <class Epi, class Sched, bool ALIGN_EPI = false, bool SP2 = false>
__device__ __forceinline__ void gemm_phase(PG8_LAS unsigned char* lds, const Gemm g, const Sched& S, const Epi& E) {
    const int tid = threadIdx.x, wid = __builtin_amdgcn_readfirstlane(tid >> 6), lane = tid & 63, wr = wid >> 2, wc = wid & 3, fr = lane & 15, fq = lane >> 4;
    const int K = g.K;
    unsigned voffA[2], voffB[2];
#pragma unroll
    for (int i = 0; i < 2; ++i) { int R, C; stage_rc(tid * 16 + i * 8192, R, C); const int Rb = Epi::PERM ? ((R & ~31) + perm32(R & 31)) : R;
        voffA[i] = (unsigned)(R * K + C) * 2u; voffB[i] = (unsigned)(Rb * K + C) * 2u; }
    const size_t kstep = (size_t)(BK * 2);
    const size_t hstep = (size_t)HALF * K * 2;
    const size_t tstep = 2 * hstep;
    const unsigned ldsw = (unsigned)wid * 1024u;
    const int aoff = lds_byte(wr * 64 + fr, fq * 8), boff = lds_byte(wc * 32 + fr, fq * 8);
#define PG8_SA(b, h) (((b) * 2 + (h)) * HTB)
#define PG8_SB(b, h) ((4 + (b) * 2 + (h)) * HTB)
#define PG8_STAGE(bufoff, gbase, voff) do { _Pragma("unroll") for (int _i = 0; _i < 2; ++_i) \
        __builtin_amdgcn_global_load_lds((const unsigned*)((const char*)(gbase) + (voff)[_i]), (PG8_LAS unsigned*)(lds + (bufoff) + ldsw + _i * 8192), 16, 0, 0); } while (0)
#define PG8_LDA(dst, b, h) do { _Pragma("unroll") for (int m = 0; m < 4; ++m) _Pragma("unroll") for (int k = 0; k < 2; ++k) dst[m][k] = *(const PG8_LAS bf16x8*)(lds + PG8_SA(b, h) + aoff + m * 2048 + k * 1024); } while (0)
#define PG8_LDB(dst, b, h) do { _Pragma("unroll") for (int n = 0; n < 2; ++n) _Pragma("unroll") for (int k = 0; k < 2; ++k) dst[n][k] = *(const PG8_LAS bf16x8*)(lds + PG8_SB(b, h) + boff + n * 2048 + k * 1024); } while (0)
#define PG8_MMA(ai, bj, At, Bt) do { __builtin_amdgcn_s_setprio(1); _Pragma("unroll") for (int m = 0; m < 4; ++m) _Pragma("unroll") for (int n = 0; n < 2; ++n) _Pragma("unroll") for (int k = 0; k < 2; ++k) \
        acc[ai][bj][m][n] = __builtin_amdgcn_mfma_f32_16x16x32_bf16(Bt[n][k], At[m][k], acc[ai][bj][m][n], 0, 0, 0); __builtin_amdgcn_s_setprio(0); } while (0)
#define PG8_WAIT_V(n) asm volatile("s_waitcnt vmcnt(" #n ")" ::: "memory")
#define PG8_WAIT_L(n) asm volatile("s_waitcnt lgkmcnt(" #n ")" ::: "memory")
#define PG8_BAR __builtin_amdgcn_s_barrier()
#define PG8_SCHED __builtin_amdgcn_sched_barrier(0)
    Unit cur, nxt; int ui = 0;
    if (!S.next(0, cur)) return;
    f32x4 acc[2][2][4][2];
#pragma unroll
    for (int a = 0; a < 2; ++a)
#pragma unroll
        for (int b = 0; b < 2; ++b)
#pragma unroll
            for (int m = 0; m < 4; ++m)
#pragma unroll
                for (int n = 0; n < 2; ++n) acc[a][b][m][n] = (f32x4){0.f, 0.f, 0.f, 0.f};
    bf16x8 At[4][2], B0[2][2], B1[2][2];
    const char* cA = (const char*)g.A + (size_t)cur.pm * tstep + (size_t)cur.kt0 * kstep; const char* cB = (const char*)g.Bt + (size_t)cur.pn * tstep + (size_t)cur.kt0 * kstep;
    S.a_ready(cur);
    if constexpr (SP2) {
        PG8_STAGE(PG8_SB(0, 0), cB, voffB); PG8_STAGE(PG8_SB(0, 1), cB + hstep, voffB); PG8_STAGE(PG8_SA(0, 0), cA, voffA); PG8_STAGE(PG8_SA(0, 1), cA + hstep, voffA);
        if (wr == 1) PG8_BAR;
        PG8_WAIT_V(2); PG8_BAR;
        PG8_STAGE(PG8_SB(1, 0), cB + kstep, voffB); PG8_STAGE(PG8_SA(1, 0), cA + kstep, voffA); PG8_STAGE(PG8_SB(1, 1), cB + hstep + kstep, voffB);
        PG8_WAIT_V(6); PG8_BAR;
    } else {
        PG8_STAGE(PG8_SB(0, 0), cB, voffB); PG8_STAGE(PG8_SA(0, 0), cA, voffA); PG8_STAGE(PG8_SB(0, 1), cB + hstep, voffB); PG8_STAGE(PG8_SA(0, 1), cA + hstep, voffA);
        if (wr == 1) PG8_BAR;
        PG8_WAIT_V(4); PG8_BAR;
        PG8_STAGE(PG8_SB(1, 0), cB + kstep, voffB); PG8_STAGE(PG8_SA(1, 0), cA + kstep, voffA); PG8_STAGE(PG8_SB(1, 1), cB + hstep + kstep, voffB);
        PG8_WAIT_V(6); PG8_BAR;
    }
    for (;;) {
        const bool has_next = S.next(ui + 1, nxt);
        const char* nA = has_next ? (const char*)g.A + (size_t)nxt.pm * tstep + (size_t)nxt.kt0 * kstep : cA; const char* nB = has_next ? (const char*)g.Bt + (size_t)nxt.pn * tstep + (size_t)nxt.kt0 * kstep : cB;
        const int nt = cur.nt;
        for (int t = 0; t < nt; t += 2) {
            const bool last = (t == nt - 2);
            const char* a1 = cA + (size_t)(t + 1) * kstep;
            const char* a2 = last ? nA : cA + (size_t)(t + 2) * kstep; const char* b2 = last ? nB : cB + (size_t)(t + 2) * kstep;
            const char* a3 = a2 + kstep; const char* b3 = b2 + kstep;
            if (last && has_next) S.a_ready(nxt);
            if constexpr (SP2) {
            PG8_LDB(B0, 0, 0); PG8_LDB(B1, 0, 1); PG8_SCHED; PG8_LDA(At, 0, 0); PG8_STAGE(PG8_SA(1, 1), a1 + hstep, voffA);
            PG8_WAIT_V(8); PG8_WAIT_L(0); PG8_BAR; PG8_MMA(0, 0, At, B0); PG8_MMA(0, 1, At, B1); PG8_BAR; PG8_SCHED;
            PG8_LDA(At, 0, 1); PG8_STAGE(PG8_SB(0, 0), b2, voffB); PG8_STAGE(PG8_SB(0, 1), b2 + hstep, voffB); PG8_STAGE(PG8_SA(0, 0), a2, voffA);
            PG8_WAIT_V(8); PG8_WAIT_L(0); PG8_BAR; PG8_MMA(1, 0, At, B0); PG8_MMA(1, 1, At, B1); PG8_BAR; PG8_SCHED;
            PG8_LDB(B0, 1, 0); PG8_LDB(B1, 1, 1); PG8_SCHED; PG8_LDA(At, 1, 0); PG8_STAGE(PG8_SA(0, 1), a2 + hstep, voffA);
            PG8_WAIT_V(8); PG8_WAIT_L(0); PG8_BAR; PG8_MMA(0, 0, At, B0); PG8_MMA(0, 1, At, B1); PG8_BAR; PG8_SCHED;
            PG8_LDA(At, 1, 1); PG8_STAGE(PG8_SB(1, 0), b3, voffB); PG8_STAGE(PG8_SB(1, 1), b3 + hstep, voffB); PG8_STAGE(PG8_SA(1, 0), a3, voffA);
            PG8_WAIT_V(8); PG8_WAIT_L(0); PG8_BAR; PG8_MMA(1, 0, At, B0); PG8_MMA(1, 1, At, B1); PG8_BAR; PG8_SCHED;
            } else {
            PG8_LDB(B0, 0, 0); PG8_SCHED; PG8_LDA(At, 0, 0); PG8_STAGE(PG8_SA(1, 1), a1 + hstep, voffA);
            PG8_WAIT_L(8); PG8_BAR; PG8_WAIT_L(0); PG8_MMA(0, 0, At, B0); PG8_BAR; PG8_SCHED;
            PG8_LDB(B1, 0, 1); PG8_STAGE(PG8_SB(0, 0), b2, voffB);
            PG8_BAR; PG8_WAIT_L(0); PG8_MMA(0, 1, At, B1); PG8_BAR;
            PG8_LDA(At, 0, 1); PG8_STAGE(PG8_SA(0, 0), a2, voffA);
            PG8_BAR; PG8_WAIT_L(0); PG8_MMA(1, 0, At, B0); PG8_BAR; PG8_SCHED;
            PG8_STAGE(PG8_SB(0, 1), b2 + hstep, voffB);
            PG8_WAIT_V(6); PG8_BAR; PG8_MMA(1, 1, At, B1); PG8_BAR;
            PG8_LDB(B0, 1, 0); PG8_SCHED; PG8_LDA(At, 1, 0); PG8_STAGE(PG8_SA(0, 1), a2 + hstep, voffA);
            PG8_WAIT_L(8); PG8_BAR; PG8_WAIT_L(0); PG8_MMA(0, 0, At, B0); PG8_BAR; PG8_SCHED;
            PG8_LDB(B1, 1, 1); PG8_STAGE(PG8_SB(1, 0), b3, voffB);
            PG8_BAR; PG8_WAIT_L(0); PG8_MMA(0, 1, At, B1); PG8_BAR;
            PG8_LDA(At, 1, 1); PG8_STAGE(PG8_SA(1, 0), a3, voffA);
            PG8_BAR; PG8_WAIT_L(0); PG8_MMA(1, 0, At, B0); PG8_BAR; PG8_SCHED;
            PG8_STAGE(PG8_SB(1, 1), b3 + hstep, voffB);
            PG8_WAIT_V(6); PG8_BAR; PG8_MMA(1, 1, At, B1); PG8_BAR;
            }
        }
        if constexpr (ALIGN_EPI) { if (wr == 0) PG8_BAR; }
        if constexpr (!Epi::AFTER_DRAIN) { E(acc, cur, wr, wc, fr, fq); S.done(cur); }
        if (!has_next) break;
#pragma unroll
        for (int a = 0; a < 2; ++a)
#pragma unroll
            for (int b = 0; b < 2; ++b)
#pragma unroll
                for (int m = 0; m < 4; ++m)
#pragma unroll
                    for (int n = 0; n < 2; ++n) acc[a][b][m][n] = (f32x4){0.f, 0.f, 0.f, 0.f};
        cur = nxt; cA = nA; cB = nB; ++ui;
        if constexpr (ALIGN_EPI) { if (wr == 1) PG8_BAR; }
    }
    PG8_WAIT_V(0);
    if constexpr (!ALIGN_EPI) { if (wr == 0) PG8_BAR; }
    PG8_BAR;
    if constexpr (Epi::AFTER_DRAIN) { E.fused(acc, cur, wr, wc, fr, fq, lds, wid, lane); S.done(cur); }
#undef PG8_SA
#undef PG8_SB
#undef PG8_STAGE
#undef PG8_LDA
#undef PG8_LDB
#undef PG8_MMA
#undef PG8_WAIT_V
#undef PG8_WAIT_L
#undef PG8_BAR
#undef PG8_SCHED
}
}

#define LAS __attribute__((address_space(3)))
typedef unsigned short bf16_t;
typedef short bf16x8 __attribute__((ext_vector_type(8)));
typedef short s16x4 __attribute__((ext_vector_type(4)));
typedef float f32x4 __attribute__((ext_vector_type(4)));
typedef float f32x2 __attribute__((ext_vector_type(2)));
typedef unsigned u32x4 __attribute__((ext_vector_type(4)));
typedef unsigned u32x2 __attribute__((ext_vector_type(2)));
using pg8::cvt_pk_bf16;

constexpr int NWAVES = 8, NTHREADS = 512;
constexpr int LDS_BYTES = 147456;
constexpr int D = 1024, TP = 16384, TS = 512, T = TP + TS, SEQ = 2048, DFF = 2816, RIN = 6144, VD = 2048;
constexpr int NROPE = SEQ + 4;
constexpr float RMS_EPS = 1e-6f, GN_EPS = 1e-6f;
constexpr size_t OUT_Y = 0, OUT_CONVP = (size_t)T * D, OUT_CONVS = OUT_CONVP + 8 * 2 * D, OUT_RETP = OUT_CONVS + 128 * 2 * D,
                 OUT_RETS = OUT_RETP + (size_t)8 * 4 * 256 * 512, OUT_END = OUT_RETS + (size_t)128 * 4 * 256 * 512;
constexpr size_t al256(size_t x) { return (x + 255) & ~(size_t)255; }
constexpr size_t WS_WCIN = 0;
constexpr size_t WS_WCOUT = WS_WCIN + (size_t)3072 * 1024 * 2;
constexpr size_t WS_WGU0 = WS_WCOUT + (size_t)1024 * 1024 * 2;
constexpr size_t WS_WGU1 = WS_WGU0 + (size_t)5632 * 1024 * 2;
constexpr size_t WS_WD0 = WS_WGU1 + (size_t)5632 * 1024 * 2;
constexpr size_t WS_WD1 = WS_WD0 + (size_t)1024 * 2816 * 2;
constexpr size_t WS_WRIN = WS_WD1 + (size_t)1024 * 2816 * 2;
constexpr size_t WS_WROUT = WS_WRIN + (size_t)6144 * 1024 * 2;
constexpr size_t WS_ROPE = WS_WROUT + (size_t)1024 * 2048 * 2;
constexpr size_t WS_PART = al256(WS_ROPE + (size_t)NROPE * 128 * 8);
constexpr size_t WS_XB = al256(WS_PART + (size_t)T * 16 * 4);
constexpr size_t WS_XRES = WS_XB + (size_t)T * D * 2;
constexpr size_t WS_R = WS_XRES + (size_t)T * D * 4;
constexpr size_t SZ_TD = (size_t)T * D * 2, SZ_TV = (size_t)T * VD * 2;
constexpr size_t WS_BB = WS_R, WS_UB = WS_R + SZ_TD, WS_A2 = WS_R + 2 * SZ_TD;
constexpr size_t WS_HFF = WS_R;
constexpr size_t WS_Q = WS_R, WS_K = WS_Q + SZ_TD, WS_V = WS_K + SZ_TD, WS_G = WS_V + SZ_TV, WS_O = WS_G + SZ_TV, WS_A8 = WS_O + SZ_TV;
constexpr size_t WS_BAR = al256(WS_A8 + SZ_TV), BAR_BYTES = 16384;
constexpr size_t WS_SPLIT = WS_BAR + BAR_BYTES;
constexpr size_t WS_END = WS_SPLIT + (size_t)11 * TS * D * 4;
constexpr int LDS_XB_ST = LDS_BYTES - 64;
static_assert((size_t)T * DFF * 2 <= WS_END - WS_R, "hff fits");


#define XB_TMO      128
#define XB_XCNT(j)  (256  + 64 * (j))
#define XB_XSUB(j)  (1280 + 64 * (j))
#define XB_XGEN(j)  (2304 + 64 * (j))
#define XB_TOP      3328
#define XB_TOPGEN   3392
#define XCD_BAR_WORDS 3456
#define XB_SPIN_CAP (1u << 18)

__device__ __forceinline__ unsigned xb_ld(unsigned* p)              { return __hip_atomic_load(p, __ATOMIC_RELAXED, __HIP_MEMORY_SCOPE_AGENT); }
__device__ __forceinline__ unsigned xb_add(unsigned* p, unsigned v) { return __hip_atomic_fetch_add(p, v, __ATOMIC_RELAXED, __HIP_MEMORY_SCOPE_AGENT); }
__device__ __forceinline__ unsigned xb_xcc_id() { return (unsigned)__builtin_amdgcn_s_getreg((3 << 11) | 20) & 0xFu; }
#define XB_SPIN(cond, bar) do { unsigned _sp = 0; while (cond) { __builtin_amdgcn_s_sleep(1); \
    if ((++_sp & 255u) == 0u) { if (xb_ld(&(bar)[XB_TMO])) break; if (_sp > XB_SPIN_CAP) { atomicAdd(&(bar)[XB_TMO], 1u); break; } } } } while (0)

struct XcdBarrier {
    unsigned* bar; unsigned x;
    volatile LAS unsigned* st;
};

__device__ __forceinline__ XcdBarrier xcd_barrier_post(unsigned* bar, volatile LAS unsigned* st) {
    XcdBarrier b; b.bar = bar; b.x = xb_xcc_id(); b.st = st;
    if (threadIdx.x == 0) (void)xb_add(&bar[XB_XCNT(b.x)], 1u);
    return b;
}
__device__ __forceinline__ void xcd_barrier_complete(unsigned* bar, unsigned x, unsigned& nloc, unsigned& nx) {
    const unsigned G = gridDim.x * gridDim.y * gridDim.z;
    unsigned sum, cnt, mine, sp = 0u;
    for (;;) {
        sum = 0u; cnt = 0u; mine = 0u;
#pragma unroll
        for (unsigned j = 0; j < 16; ++j) { const unsigned c = xb_ld(&bar[XB_XCNT(j)]); sum += c; cnt += (c > 0u) ? 1u : 0u; mine = (j == x) ? c : mine; }
        if (sum == G) break;
        __builtin_amdgcn_s_sleep(1);
        if ((++sp & 255u) == 0u) { if (xb_ld(&bar[XB_TMO])) break; if (sp > XB_SPIN_CAP) { atomicAdd(&bar[XB_TMO], 1u); break; } }
    }
    nloc = mine > 0u ? mine : 1u; nx = cnt > 0u ? cnt : 1u;
}

__device__ __forceinline__ void xcd_barrier(const XcdBarrier& b) {
    asm volatile("s_waitcnt vmcnt(0)" ::: "memory");
    __syncthreads();
    if (threadIdx.x == 0) {
        unsigned* bar = b.bar;
        __builtin_amdgcn_s_waitcnt(0);
        unsigned nloc = b.st[0], nx = b.st[1];
        if (nloc == 0u) { xcd_barrier_complete(bar, b.x, nloc, nx); b.st[0] = nloc; b.st[1] = nx; }
        const unsigned old = xb_add(&bar[XB_XSUB(b.x)], 1u);
        const unsigned gen = old / nloc;
        if (old + 1u == (gen + 1u) * nloc) {
            __builtin_amdgcn_fence(__ATOMIC_RELEASE, "agent");
            asm volatile("s_waitcnt vmcnt(0)" ::: "memory");
            const unsigned og = xb_add(&bar[XB_TOP], 1u);
            const unsigned tg = og / nx;
            if (og + 1u == (tg + 1u) * nx) xb_add(&bar[XB_TOPGEN], 1u);
            else XB_SPIN(xb_ld(&bar[XB_TOPGEN]) == tg, bar);
            __builtin_amdgcn_fence(__ATOMIC_ACQUIRE, "agent");
            xb_add(&bar[XB_XGEN(b.x)], 1u);
            asm volatile("s_waitcnt vmcnt(0)" ::: "memory");
        } else {
            XB_SPIN(xb_ld(&bar[XB_XGEN(b.x)]) == gen, bar);
            __builtin_amdgcn_fence(__ATOMIC_ACQUIRE, "agent");
            asm volatile("s_waitcnt vmcnt(0)" ::: "memory");
        }
    }
    __syncthreads();
}

static_assert(XCD_BAR_WORDS * 4 <= BAR_BYTES, "barrier words");
struct Params { const float* in[16]; float* out; unsigned char* ws; int ph_lo, ph_hi; };

__device__ __forceinline__ float wave_sum(float v) {
#pragma unroll
    for (int o = 1; o < 64; o <<= 1) v += __shfl_xor(v, o);
    return v;
}
__device__ __forceinline__ float silu_f(float x) { return x * __builtin_amdgcn_rcpf(1.0f + __expf(-x)); }
__device__ __forceinline__ float bf2f(unsigned short b) { return __builtin_bit_cast(float, (unsigned)b << 16); }
__device__ __forceinline__ float bflo(unsigned w) { return __builtin_bit_cast(float, w << 16); }
__device__ __forceinline__ float bfhi(unsigned w) { return __builtin_bit_cast(float, w & 0xffff0000u); }
__device__ __forceinline__ u32x4 pack8(const f32x4 a, const f32x4 b) { u32x4 w; w.x = cvt_pk_bf16(a[0], a[1]); w.y = cvt_pk_bf16(a[2], a[3]); w.z = cvt_pk_bf16(b[0], b[1]); w.w = cvt_pk_bf16(b[2], b[3]); return w; }
__device__ __forceinline__ float row_rs(const float* part, int row) {
    const f32x4* p = (const f32x4*)(part + (size_t)row * 16);
    const f32x4 a = p[0], b = p[1], c = p[2], d = p[3];
    const float s = (((a[0] + a[1]) + (a[2] + a[3])) + ((b[0] + b[1]) + (b[2] + b[3]))) + (((c[0] + c[1]) + (c[2] + c[3])) + ((d[0] + d[1]) + (d[2] + d[3])));
    return rsqrtf(s * (1.0f / D) + RMS_EPS);
}

typedef f32x4 Acc[2][2][4][2];

struct EpiConvIn {
    static constexpr bool PERM = true, AFTER_DRAIN = false;
    const float* part; bf16_t* bb; bf16_t* ub; float* convp; float* convs;
    __device__ __forceinline__ void operator()(const Acc& acc, const pg8::Unit& u, int wr, int wc, int fr, int fq) const {
#pragma unroll
        for (int ai = 0; ai < 2; ++ai)
#pragma unroll
            for (int m = 0; m < 4; ++m) {
                const int row = u.pm * 256 + ai * 128 + wr * 64 + m * 16 + fr;
                const float rs = row_rs(part, row);
                if (u.pn < 4) {
#pragma unroll
                    for (int bj = 0; bj < 2; ++bj) { const int col = u.pn * 256 + bj * 128 + wc * 32 + 8 * fq;
                        *(u32x4*)(bb + (size_t)row * D + col) = pack8(acc[ai][bj][m][0] * rs, acc[ai][bj][m][1] * rs); }
                } else {
                    const int col = (u.pn - 4) * 128 + wc * 32 + 8 * fq;
                    const f32x4 u0 = (acc[ai][0][m][0] * rs) * (acc[ai][1][m][0] * rs), u1 = (acc[ai][0][m][1] * rs) * (acc[ai][1][m][1] * rs);
                    *(u32x4*)(ub + (size_t)row * D + col) = pack8(u0, u1);
                    float* dst = nullptr;
                    if (row < TP) { const int l = row & (SEQ - 1); if (l >= SEQ - 2) dst = convp + ((size_t)(row >> 11) * 2 + (l - (SEQ - 2))) * D + col; }
                    else { const int ts = row - TP, l = ts & 3; if (l >= 2) dst = convs + ((size_t)(ts >> 2) * 2 + (l - 2)) * D + col; }
                    if (dst) { *(f32x4*)dst = u0; *(f32x4*)(dst + 4) = u1; }
                }
            }
    }
};

template <int MODE> struct EpiResid {
    static constexpr bool PERM = true, AFTER_DRAIN = false;
    const float* xp; const float* xs; float* xres; bf16_t* xb; float* part; float* split;
    __device__ __forceinline__ void operator()(const Acc& acc, const pg8::Unit& u, int wr, int wc, int fr, int fq) const {
        if (u.pm >= TP / 256) {
#pragma unroll
            for (int ai = 0; ai < 2; ++ai)
#pragma unroll
                for (int m = 0; m < 4; ++m) {
                    const int row = u.pm * 256 + ai * 128 + wr * 64 + m * 16 + fr;
#pragma unroll
                    for (int bj = 0; bj < 2; ++bj) { float* dst = split + ((size_t)(u.kt0 >> 2) * TS + (row - TP)) * D + u.pn * 256 + bj * 128 + wc * 32 + 8 * fq;
                        *(f32x4*)dst = acc[ai][bj][m][0]; *(f32x4*)(dst + 4) = acc[ai][bj][m][1]; }
                }
            return;
        }
#pragma unroll
        for (int ai = 0; ai < 2; ++ai)
#pragma unroll
            for (int m = 0; m < 4; ++m) {
                const int row = u.pm * 256 + ai * 128 + wr * 64 + m * 16 + fr;
                const float* src = row < TP ? xp + (size_t)row * D : xs + (size_t)(row - TP) * D;
                float ss = 0.f;
#pragma unroll
                for (int bj = 0; bj < 2; ++bj) { const int col = u.pn * 256 + bj * 128 + wc * 32 + 8 * fq;
                    f32x4 r0, r1;
                    if (MODE == 0) { r0 = *(const f32x4*)(src + col); r1 = *(const f32x4*)(src + col + 4); }
                    else { const u32x4 w = *(const u32x4*)(xb + (size_t)row * D + col); r0 = (f32x4){bflo(w.x), bfhi(w.x), bflo(w.y), bfhi(w.y)}; r1 = (f32x4){bflo(w.z), bfhi(w.z), bflo(w.w), bfhi(w.w)}; }
                    const f32x4 v0 = acc[ai][bj][m][0] + r0, v1 = acc[ai][bj][m][1] + r1;
                    *(u32x4*)(xb + (size_t)row * D + col) = pack8(v0, v1);
                    if (MODE != 2) {
                        ss += ((v0[0] * v0[0] + v0[1] * v0[1]) + (v0[2] * v0[2] + v0[3] * v0[3])) + ((v1[0] * v1[0] + v1[1] * v1[1]) + (v1[2] * v1[2] + v1[3] * v1[3])); } }
                if (MODE != 2) { ss += __shfl_xor(ss, 16); ss += __shfl_xor(ss, 32);
                    if (fq == 0) part[(size_t)row * 16 + u.pn * 4 + wc] = ss; }
            }
    }
};

struct EpiSwiGLU {
    static constexpr bool PERM = true, AFTER_DRAIN = false;
    const float* part; bf16_t* hff;
    __device__ __forceinline__ void operator()(const Acc& acc, const pg8::Unit& u, int wr, int wc, int fr, int fq) const {
#pragma unroll
        for (int ai = 0; ai < 2; ++ai)
#pragma unroll
            for (int m = 0; m < 4; ++m) {
                const int row = u.pm * 256 + ai * 128 + wr * 64 + m * 16 + fr;
                const float rs = row_rs(part, row);
                const int col = u.pn * 128 + wc * 32 + 8 * fq;
                f32x4 h[2];
#pragma unroll
                for (int n = 0; n < 2; ++n)
#pragma unroll
                    for (int e = 0; e < 4; ++e) h[n][e] = silu_f(acc[ai][0][m][n][e] * rs) * (acc[ai][1][m][n][e] * rs);
                *(u32x4*)(hff + (size_t)row * DFF + col) = pack8(h[0], h[1]);
            }
    }
};

struct EpiRetIn {
    static constexpr bool PERM = true, AFTER_DRAIN = false;
    const float* part; const float* rope; bf16_t* Q; bf16_t* K; bf16_t* V; bf16_t* G;
    __device__ __forceinline__ void operator()(const Acc& acc, const pg8::Unit& u, int wr, int wc, int fr, int fq) const {
#pragma unroll
        for (int ai = 0; ai < 2; ++ai)
#pragma unroll
            for (int m = 0; m < 4; ++m) {
                const int row = u.pm * 256 + ai * 128 + wr * 64 + m * 16 + fr;
                const float rs = row_rs(part, row);
                if (u.pn < 8) {
                    const int pidx = row < TP ? (row & (SEQ - 1)) : SEQ + ((row - TP) & 3);
                    const int i0 = wc * 32 + 8 * fq;
                    const f32x4* cs = (const f32x4*)(rope + ((size_t)pidx * 128 + i0) * 2);
                    const float sc = (u.pn < 4) ? rs : rs * 0.0625f;
                    f32x4 o1[2], o2[2];
#pragma unroll
                    for (int n = 0; n < 2; ++n) { const f32x4 c01 = cs[2 * n], c23 = cs[2 * n + 1];
                        const f32x4 x1 = acc[ai][0][m][n] * sc, x2 = acc[ai][1][m][n] * sc;
                        const f32x4 cc = (f32x4){c01[0], c01[2], c23[0], c23[2]}, sn = (f32x4){c01[1], c01[3], c23[1], c23[3]};
                        o1[n] = x1 * cc - x2 * sn; o2[n] = x1 * sn + x2 * cc; }
                    bf16_t* dst = (u.pn < 4 ? Q : K) + (size_t)row * D + (u.pn & 3) * 256 + i0;
                    *(u32x4*)dst = pack8(o1[0], o1[1]); *(u32x4*)(dst + 128) = pack8(o2[0], o2[1]);
                } else if (u.pn < 16) {
#pragma unroll
                    for (int bj = 0; bj < 2; ++bj) { const int col = (u.pn - 8) * 256 + bj * 128 + wc * 32 + 8 * fq;
                        *(u32x4*)(V + (size_t)row * VD + col) = pack8(acc[ai][bj][m][0] * rs, acc[ai][bj][m][1] * rs); }
                } else {
#pragma unroll
                    for (int bj = 0; bj < 2; ++bj) { const int col = (u.pn - 16) * 256 + bj * 128 + wc * 32 + 8 * fq;
                        f32x4 g[2];
#pragma unroll
                        for (int n = 0; n < 2; ++n)
#pragma unroll
                            for (int e = 0; e < 4; ++e) g[n][e] = silu_f(acc[ai][bj][m][n][e] * rs);
                        *(u32x4*)(G + (size_t)row * VD + col) = pack8(g[0], g[1]); }
                }
            }
    }
};

__device__ __forceinline__ void transpose_item(const float* W, int K, int N, const float* gain, bf16_t* WT, int kind, LAS float* scr, int item, int lane) {
    const int nblk = N / 32, kb = item / nblk, nb = item % nblk, k0 = 64 * kb, n0 = 32 * nb;
    int drow;
    if (kind == 0) drow = n0;
    else if (kind == 1) { if (n0 < 1024) drow = n0; else { const int hh = (n0 - 1024) >> 10, j = (n0 - 1024) & 1023; drow = 1024 + (j >> 7) * 256 + hh * 128 + (j & 127); } }
    else if (kind == 2) drow = (n0 >> 7) * 256 + (n0 & 127);
    else drow = (n0 >> 7) * 256 + 128 + (n0 & 127);
    { const int kq = lane >> 3, n4 = (lane & 7) * 4;
        f32x4 v[8];
#pragma unroll
        for (int i = 0; i < 8; ++i) v[i] = *(const f32x4*)(W + (size_t)(k0 + kq + 8 * i) * N + n0 + n4);
        if (gain) {
#pragma unroll
            for (int i = 0; i < 8; ++i) v[i] = v[i] * gain[k0 + kq + 8 * i]; }
#pragma unroll
        for (int i = 0; i < 8; ++i) { LAS float* d = scr + (kq + 8 * i) * 33 + n4; d[0] = v[i][0]; d[1] = v[i][1]; d[2] = v[i][2]; d[3] = v[i][3]; } }
    asm volatile("s_waitcnt lgkmcnt(0)" ::: "memory");
    const int c = lane & 7;
#pragma unroll
    for (int j = 0; j < 4; ++j) { const int n = (lane >> 3) + 8 * j; const LAS float* s = scr + (8 * c) * 33 + n;
        u32x4 o; o.x = cvt_pk_bf16(s[0 * 33], s[1 * 33]); o.y = cvt_pk_bf16(s[2 * 33], s[3 * 33]); o.z = cvt_pk_bf16(s[4 * 33], s[5 * 33]); o.w = cvt_pk_bf16(s[6 * 33], s[7 * 33]);
        *(u32x4*)(WT + (size_t)(drow + n) * K + k0 + 8 * c) = o; }
    asm volatile("s_waitcnt lgkmcnt(0)" ::: "memory");
}

__device__ __forceinline__ void transpose_group(const Params& p, LAS unsigned char* lds, int grp, int gw, int NGW) {
    const int lane = threadIdx.x & 63, wave = __builtin_amdgcn_readfirstlane(threadIdx.x >> 6);
    LAS float* scr = (LAS float*)(lds + wave * 16384);
    unsigned char* ws = p.ws;
    constexpr int I_CIN = 16 * 96, I_COUT = 16 * 32, I_G = 16 * 88, I_D = 44 * 32, I_RIN = 16 * 192, I_ROUT = 32 * 32;
    if (grp == 0) {
        for (int r = gw; r < I_CIN; r += NGW) transpose_item(p.in[6], 1024, 3072, p.in[4], (bf16_t*)(ws + WS_WCIN), 1, scr, r, lane);
    } else if (grp == 1) {
        for (int it = gw; it < I_COUT + 2 * I_G + I_D; it += NGW) { int r = it;
            if (r < I_COUT) { transpose_item(p.in[8], 1024, 1024, nullptr, (bf16_t*)(ws + WS_WCOUT), 0, scr, r, lane); continue; } r -= I_COUT;
            if (r < I_G) { transpose_item(p.in[12], 1024, DFF, p.in[5], (bf16_t*)(ws + WS_WGU0), 2, scr, r, lane); continue; } r -= I_G;
            if (r < I_G) { transpose_item(p.in[13], 1024, DFF, p.in[5], (bf16_t*)(ws + WS_WGU0), 3, scr, r, lane); continue; } r -= I_G;
            transpose_item(p.in[14], DFF, 1024, nullptr, (bf16_t*)(ws + WS_WD0), 0, scr, r, lane); }
    } else if (grp == 2) {
        for (int r = gw; r < I_RIN; r += NGW) transpose_item(p.in[9], 1024, RIN, p.in[4] + D, (bf16_t*)(ws + WS_WRIN), 0, scr, r, lane);
    } else {
        for (int it = gw; it < I_ROUT + 2 * I_G + I_D; it += NGW) { int r = it;
            if (r < I_ROUT) { transpose_item(p.in[11], VD, 1024, p.in[10], (bf16_t*)(ws + WS_WROUT), 0, scr, r, lane); continue; } r -= I_ROUT;
            if (r < I_G) { transpose_item(p.in[12] + (size_t)1024 * DFF, 1024, DFF, p.in[5] + D, (bf16_t*)(ws + WS_WGU1), 2, scr, r, lane); continue; } r -= I_G;
            if (r < I_G) { transpose_item(p.in[13] + (size_t)1024 * DFF, 1024, DFF, p.in[5] + D, (bf16_t*)(ws + WS_WGU1), 3, scr, r, lane); continue; } r -= I_G;
            transpose_item(p.in[14] + (size_t)DFF * 1024, DFF, 1024, nullptr, (bf16_t*)(ws + WS_WD1), 0, scr, r, lane); }
    }
}
__device__ __forceinline__ void idle_slot_transposes(const Params& p, LAS unsigned char* lds, int grp, int nwg, int G, int bx) {
    if (G != 256) return;
    const int R = (nwg + G - 1) / G, busy = nwg - (R - 1) * G;
    if (bx < busy) return;
    const int wave = __builtin_amdgcn_readfirstlane(threadIdx.x >> 6);
    transpose_group(p, lds, grp, (bx - busy) * NWAVES + wave, (G - busy) * NWAVES);
}
__device__ __forceinline__ void phase_prologue(const Params& p, LAS unsigned char* lds, int vcu, int G) {
    const int tid = threadIdx.x, lane = tid & 63, wave = __builtin_amdgcn_readfirstlane(tid >> 6);
    LAS float* scr = (LAS float*)(lds + wave * 16384);
    const int gw = vcu * NWAVES + wave, NGW = G * NWAVES;
    unsigned char* ws = p.ws;
    if (G == 256) transpose_group(p, lds, 0, gw, NGW);
    else { for (int grp = 0; grp < 4; ++grp) transpose_group(p, lds, grp, gw, NGW); }
    bf16_t* xb = (bf16_t*)(ws + WS_XB); float* part = (float*)(ws + WS_PART);
    for (int rowb = gw * 2; rowb < T; rowb += NGW * 2) {
      f32x4 xv[2][4];
#pragma unroll
      for (int k = 0; k < 2; ++k) { const int row = rowb + k; const float* xr = row < TP ? p.in[0] + (size_t)row * D : p.in[1] + (size_t)(row - TP) * D;
#pragma unroll
        for (int j = 0; j < 2; ++j) { xv[k][2 * j] = __builtin_nontemporal_load((const f32x4*)(xr + j * 512 + lane * 8)); xv[k][2 * j + 1] = __builtin_nontemporal_load((const f32x4*)(xr + j * 512 + lane * 8 + 4)); } }
#pragma unroll
      for (int k = 0; k < 2; ++k) { const int row = rowb + k; const float* xr = row < TP ? p.in[0] + (size_t)row * D : p.in[1] + (size_t)(row - TP) * D;
        float ss = 0.f;
#pragma unroll
        for (int j = 0; j < 2; ++j) { const int col = j * 512 + lane * 8;
            const f32x4 v0 = xv[k][2 * j], v1 = xv[k][2 * j + 1];
            *(u32x4*)(xb + (size_t)row * D + col) = pack8(v0, v1);
            ss += ((v0[0] * v0[0] + v0[1] * v0[1]) + (v0[2] * v0[2] + v0[3] * v0[3])) + ((v1[0] * v1[0] + v1[1] * v1[1]) + (v1[2] * v1[2] + v1[3] * v1[3])); }
        ss = wave_sum(ss);
        if (lane < 16) part[(size_t)row * 16 + lane] = (lane == 0) ? ss : 0.f;
    } }
    float* rope = (float*)(ws + WS_ROPE);
    for (int e = vcu * NTHREADS + tid; e < NROPE * 128; e += G * NTHREADS) {
        const int pi = e >> 7, i = e & 127;
        const double pos = pi < SEQ ? (double)pi : (double)(16384 + (pi - SEQ));
        const double inv = exp2(-(double)i * (13.287712379549449 / 128.0));
        const double ang = pos * inv;
        const double n = rint(ang * 0.15915494309189535);
        const float r = (float)(ang - n * 6.283185307179586);
        rope[2 * e] = __cosf(r); rope[2 * e + 1] = __sinf(r);
    }
}

__device__ __forceinline__ void unpack8(const u32x4 w, float* f) { f[0] = bflo(w.x); f[1] = bfhi(w.x); f[2] = bflo(w.y); f[3] = bfhi(w.y); f[4] = bflo(w.z); f[5] = bfhi(w.z); f[6] = bflo(w.w); f[7] = bfhi(w.w); }
__device__ __forceinline__ void phase_conv_sample(const Params& p, int vcu, int G) {
    unsigned char* ws = p.ws;
    const bf16_t* bb = (const bf16_t*)(ws + WS_BB); const bf16_t* ub = (const bf16_t*)(ws + WS_UB); bf16_t* a2 = (bf16_t*)(ws + WS_A2);
    const float* cw = p.in[7]; const float* sc = p.in[2];
    for (int it = TP * 128 + vcu * NTHREADS + threadIdx.x; it < T * 128; it += G * NTHREADS) {
        const int row = it >> 7, col = (it & 127) * 8;
        float b[8], u0[8], u1[8], u2[8];
        unpack8(*(const u32x4*)(bb + (size_t)row * D + col), b);
        unpack8(*(const u32x4*)(ub + (size_t)row * D + col), u2);
        int l; const float* buf = nullptr;
        if (row < TP) l = row & (SEQ - 1); else { const int ts = row - TP; l = ts & 3; buf = sc + (size_t)(ts >> 2) * 2 * D + col; }
        if (l >= 1) unpack8(*(const u32x4*)(ub + (size_t)(row - 1) * D + col), u1);
        else if (buf) { const f32x4 a = *(const f32x4*)(buf + D), c = *(const f32x4*)(buf + D + 4); u1[0] = a[0]; u1[1] = a[1]; u1[2] = a[2]; u1[3] = a[3]; u1[4] = c[0]; u1[5] = c[1]; u1[6] = c[2]; u1[7] = c[3]; }
        else {
#pragma unroll
            for (int e = 0; e < 8; ++e) u1[e] = 0.f; }
        if (l >= 2) unpack8(*(const u32x4*)(ub + (size_t)(row - 2) * D + col), u0);
        else if (buf) { const float* q = buf + (size_t)l * D; const f32x4 a = *(const f32x4*)q, c = *(const f32x4*)(q + 4); u0[0] = a[0]; u0[1] = a[1]; u0[2] = a[2]; u0[3] = a[3]; u0[4] = c[0]; u0[5] = c[1]; u0[6] = c[2]; u0[7] = c[3]; }
        else {
#pragma unroll
            for (int e = 0; e < 8; ++e) u0[e] = 0.f; }
        f32x4 o[2];
#pragma unroll
        for (int e = 0; e < 8; ++e) { const float y = cw[col + e] * u0[e] + cw[D + col + e] * u1[e] + cw[2 * D + col + e] * u2[e]; o[e >> 2][e & 3] = b[e] * y; }
        *(u32x4*)(a2 + (size_t)row * D + col) = pack8(o[0], o[1]);
    }
}

__device__ __forceinline__ void phase_conv(const Params& p, int vcu, int G) {
    unsigned char* ws = p.ws;
    const bf16_t* bb = (const bf16_t*)(ws + WS_BB); const bf16_t* ub = (const bf16_t*)(ws + WS_UB); bf16_t* a2 = (bf16_t*)(ws + WS_A2);
    const float* cw = p.in[7];
    const int col = (threadIdx.x & 127) * 8;
    float w0[8], w1[8], w2[8];
#pragma unroll
    for (int e = 0; e < 8; ++e) { w0[e] = cw[col + e]; w1[e] = cw[D + col + e]; w2[e] = cw[2 * D + col + e]; }
    const int rstride = G * 4;
    for (int r0 = vcu * 4 + (threadIdx.x >> 7); r0 < TP; r0 += 4 * rstride) {
        u32x4 vb[4], v2[4], v1[4], v0[4];
#pragma unroll
        for (int k = 0; k < 4; ++k) { const int row = r0 + k * rstride; if (row < TP) { const int l = row & (SEQ - 1);
            vb[k] = __builtin_nontemporal_load((const u32x4*)(bb + (size_t)row * D + col)); v2[k] = *(const u32x4*)(ub + (size_t)row * D + col);
            v1[k] = *(const u32x4*)(ub + (size_t)(row - (l >= 1 ? 1 : 0)) * D + col); v0[k] = *(const u32x4*)(ub + (size_t)(row - (l >= 2 ? 2 : 0)) * D + col); } }
#pragma unroll
        for (int k = 0; k < 4; ++k) { const int row = r0 + k * rstride; if (row < TP) { const int l = row & (SEQ - 1);
            float b[8], u0[8], u1[8], u2[8]; unpack8(vb[k], b); unpack8(v2[k], u2); unpack8(v1[k], u1); unpack8(v0[k], u0);
            const float m1 = l >= 1 ? 1.f : 0.f, m0 = l >= 2 ? 1.f : 0.f;
            f32x4 o[2];
#pragma unroll
            for (int e = 0; e < 8; ++e) { const float y = w0[e] * (u0[e] * m0) + w1[e] * (u1[e] * m1) + w2[e] * u2[e]; o[e >> 2][e & 3] = b[e] * y; }
            *(u32x4*)(a2 + (size_t)row * D + col) = pack8(o[0], o[1]); } }
    }
    phase_conv_sample(p, vcu, G);
}

__device__ __forceinline__ bf16x8 tr_read2(LAS const unsigned char* a0, LAS const unsigned char* a1) {
    const s16x4 a = __builtin_amdgcn_ds_read_tr16_b64_v4i16((LAS s16x4*)a0);
    const s16x4 b = __builtin_amdgcn_ds_read_tr16_b64_v4i16((LAS s16x4*)a1);
    return (bf16x8){a[0], a[1], a[2], a[3], b[0], b[1], b[2], b[3]};
}
constexpr int KS_STRIDE = 528, VS_STRIDE = 144, ST_STRIDE = 528;
constexpr int LDS_KS = 0, LDS_VS = LDS_KS + 128 * KS_STRIDE, LDS_VW = LDS_VS + 128 * VS_STRIDE, LDS_ST = LDS_VW + 128 * VS_STRIDE, LDS_RET_END = LDS_ST + 64 * ST_STRIDE;
static_assert(LDS_RET_END <= LDS_BYTES, "retention LDS");

__device__ __forceinline__ void retention_prompt_unit(const Params& p, LAS unsigned char* lds, int unit) {
    const int tid = threadIdx.x, lane = tid & 63, wid = __builtin_amdgcn_readfirstlane(tid >> 6), fr = lane & 15, fq = lane >> 4;
    const int b = unit >> 5, h = (unit >> 3) & 3, vb = unit & 7;
    unsigned char* ws = p.ws;
    const bf16_t* Qg = (const bf16_t*)(ws + WS_Q) + (size_t)b * SEQ * D + h * 256;
    const bf16_t* Kg = (const bf16_t*)(ws + WS_K) + (size_t)b * SEQ * D + h * 256;
    const bf16_t* Vg = (const bf16_t*)(ws + WS_V) + (size_t)b * SEQ * VD + h * 512 + vb * 64;
    bf16_t* Og = (bf16_t*)(ws + WS_O) + (size_t)b * SEQ * VD + h * 512 + vb * 64;
    const float log2g = __log2f(1.0f - exp2f(-5.0f - (float)h));
    const float gC = exp2f(128.0f * log2g);
    f32x4 S[2][4];
#pragma unroll
    for (int mt = 0; mt < 2; ++mt)
#pragma unroll
        for (int nt = 0; nt < 4; ++nt) S[mt][nt] = (f32x4){0.f, 0.f, 0.f, 0.f};
    LAS unsigned char* Ks = lds + LDS_KS; LAS unsigned char* Vs = lds + LDS_VS; LAS unsigned char* Vw = lds + LDS_VW; LAS unsigned char* St = lds + LDS_ST;
    for (int c = 0; c < 16; ++c) {
        __syncthreads();
#pragma unroll
        for (int mt = 0; mt < 2; ++mt)
#pragma unroll
            for (int nt = 0; nt < 4; ++nt) { u32x2 w; w.x = cvt_pk_bf16(S[mt][nt][0], S[mt][nt][1]); w.y = cvt_pk_bf16(S[mt][nt][2], S[mt][nt][3]);
                *(LAS u32x2*)(St + (nt * 16 + fr) * ST_STRIDE + (32 * wid + 16 * mt + fq * 4) * 2) = w; }
#pragma unroll
        for (int i = 0; i < 8; ++i) { const int id = tid + i * NTHREADS, row = id >> 5, cc = id & 31;
            *(LAS u32x4*)(Ks + row * KS_STRIDE + cc * 16) = *(const u32x4*)(Kg + (size_t)(c * 128 + row) * D + cc * 8); }
#pragma unroll
        for (int i = 0; i < 2; ++i) { const int id = tid + i * NTHREADS, row = id >> 3, cc = id & 7;
            const u32x4 v = *(const u32x4*)(Vg + (size_t)(c * 128 + row) * VD + cc * 8);
            *(LAS u32x4*)(Vs + row * VS_STRIDE + cc * 16) = v;
            const float sw = exp2f((float)(127 - row) * log2g);
            u32x4 w; w.x = cvt_pk_bf16(bflo(v.x) * sw, bfhi(v.x) * sw); w.y = cvt_pk_bf16(bflo(v.y) * sw, bfhi(v.y) * sw); w.z = cvt_pk_bf16(bflo(v.z) * sw, bfhi(v.z) * sw); w.w = cvt_pk_bf16(bflo(v.w) * sw, bfhi(v.w) * sw);
            *(LAS u32x4*)(Vw + row * VS_STRIDE + cc * 16) = w; }
        bf16x8 qf[8];
#pragma unroll
        for (int ks = 0; ks < 8; ++ks) qf[ks] = *(const bf16x8*)(Qg + (size_t)(c * 128 + 16 * wid + fr) * D + ks * 32 + fq * 8);
        __syncthreads();
        f32x4 sc[8];
#pragma unroll
        for (int jt = 0; jt < 8; ++jt) {
            sc[jt] = (f32x4){0.f, 0.f, 0.f, 0.f};
            if (jt <= wid) {
#pragma unroll
                for (int ks = 0; ks < 8; ++ks) { const bf16x8 kf = *(const LAS bf16x8*)(Ks + (jt * 16 + fr) * KS_STRIDE + ks * 64 + fq * 16);
                    sc[jt] = __builtin_amdgcn_mfma_f32_16x16x32_bf16(kf, qf[ks], sc[jt], 0, 0, 0); }
#pragma unroll
                for (int r = 0; r < 4; ++r) { const int dij = 16 * (wid - jt) + fr - fq * 4 - r;
                    sc[jt][r] = dij >= 0 ? sc[jt][r] * exp2f((float)dij * log2g) : 0.f; }
            }
        }
        f32x4 o[4];
#pragma unroll
        for (int nt = 0; nt < 4; ++nt) {
            o[nt] = (f32x4){0.f, 0.f, 0.f, 0.f};
#pragma unroll
            for (int ks = 0; ks < 8; ++ks) { const bf16x8 sf = *(const LAS bf16x8*)(St + (nt * 16 + fr) * ST_STRIDE + ks * 64 + fq * 16);
                o[nt] = __builtin_amdgcn_mfma_f32_16x16x32_bf16(qf[ks], sf, o[nt], 0, 0, 0); }
#pragma unroll
            for (int r = 0; r < 4; ++r) o[nt][r] *= exp2f((float)(16 * wid + fq * 4 + r + 1) * log2g);
        }
#pragma unroll
        for (int a = 0; a < 4; ++a) {
            if (2 * a <= wid) {
                bf16x8 pa; { const unsigned w0 = cvt_pk_bf16(sc[2 * a][0], sc[2 * a][1]), w1 = cvt_pk_bf16(sc[2 * a][2], sc[2 * a][3]), w2 = cvt_pk_bf16(sc[2 * a + 1][0], sc[2 * a + 1][1]), w3 = cvt_pk_bf16(sc[2 * a + 1][2], sc[2 * a + 1][3]);
                    const u32x4 w = (u32x4){w0, w1, w2, w3}; pa = __builtin_bit_cast(bf16x8, w); }
#pragma unroll
                for (int nt = 0; nt < 4; ++nt) {
                    LAS const unsigned char* a0 = Vs + (32 * a + fq * 4 + (fr >> 2)) * VS_STRIDE + (nt * 16 + 4 * (fr & 3)) * 2;
                    const bf16x8 vf = tr_read2(a0, a0 + 16 * VS_STRIDE);
                    o[nt] = __builtin_amdgcn_mfma_f32_16x16x32_bf16(pa, vf, o[nt], 0, 0, 0); }
            }
        }
#pragma unroll
        for (int nt = 0; nt < 4; ++nt)
#pragma unroll
            for (int r = 0; r < 4; ++r) Og[(size_t)(c * 128 + 16 * wid + fq * 4 + r) * VD + nt * 16 + fr] = (bf16_t)(cvt_pk_bf16(o[nt][r], 0.f) & 0xffffu);
#pragma unroll
        for (int mt = 0; mt < 2; ++mt)
#pragma unroll
            for (int nt = 0; nt < 4; ++nt) S[mt][nt] = S[mt][nt] * gC;
#pragma unroll
        for (int ks = 0; ks < 4; ++ks) {
            bf16x8 af[2];
#pragma unroll
            for (int mt = 0; mt < 2; ++mt) { LAS const unsigned char* a0 = Ks + (ks * 32 + fq * 8 + (fr >> 2)) * KS_STRIDE + (32 * wid + 16 * mt + 4 * (fr & 3)) * 2;
                af[mt] = tr_read2(a0, a0 + 4 * KS_STRIDE); }
#pragma unroll
            for (int nt = 0; nt < 4; ++nt) { LAS const unsigned char* b0 = Vw + (ks * 32 + fq * 8 + (fr >> 2)) * VS_STRIDE + (nt * 16 + 4 * (fr & 3)) * 2;
                const bf16x8 bfr = tr_read2(b0, b0 + 4 * VS_STRIDE);
#pragma unroll
                for (int mt = 0; mt < 2; ++mt) S[mt][nt] = __builtin_amdgcn_mfma_f32_16x16x32_bf16(af[mt], bfr, S[mt][nt], 0, 0, 0); }
        }
    }
    float* So = p.out + OUT_RETP + ((size_t)(b * 4 + h) * 256) * 512 + vb * 64;
#pragma unroll
    for (int mt = 0; mt < 2; ++mt)
#pragma unroll
        for (int nt = 0; nt < 4; ++nt)
#pragma unroll
            for (int r = 0; r < 4; ++r) So[(size_t)(32 * wid + 16 * mt + fq * 4 + r) * 512 + nt * 16 + fr] = S[mt][nt][r];
}

constexpr int LDS_SQ = 0, LDS_SK = 4096, LDS_SA = 8192, LDS_SRED = 8448;
__device__ __forceinline__ void retention_sample_unit(const Params& p, LAS unsigned char* lds, int unit) {
    const int tid = threadIdx.x, lane = tid & 63, wid = __builtin_amdgcn_readfirstlane(tid >> 6);
    const int s = unit >> 2, h = unit & 3, t0 = TP + s * 4;
    unsigned char* ws = p.ws;
    const bf16_t* Qg = (const bf16_t*)(ws + WS_Q) + (size_t)t0 * D + h * 256;
    const bf16_t* Kg = (const bf16_t*)(ws + WS_K) + (size_t)t0 * D + h * 256;
    const bf16_t* Vg = (const bf16_t*)(ws + WS_V) + (size_t)t0 * VD + h * 512;
    bf16_t* Og = (bf16_t*)(ws + WS_O) + (size_t)t0 * VD + h * 512;
    const float g = 1.0f - exp2f(-5.0f - (float)h), g2 = g * g, g3 = g2 * g, g4 = g2 * g2;
    LAS f32x4* qs = (LAS f32x4*)(lds + LDS_SQ); LAS f32x4* kws = (LAS f32x4*)(lds + LDS_SK); LAS float* asc = (LAS float*)(lds + LDS_SA); LAS float* red = (LAS float*)(lds + LDS_SRED);
    __syncthreads();
    if (tid < 256) { const int d = tid;
        qs[d] = (f32x4){bf2f(Qg[d]), bf2f(Qg[D + d]), bf2f(Qg[2 * D + d]), bf2f(Qg[3 * D + d])};
        kws[d] = (f32x4){g3 * bf2f(Kg[d]), g2 * bf2f(Kg[D + d]), g * bf2f(Kg[2 * D + d]), bf2f(Kg[3 * D + d])}; }
#pragma unroll
    for (int e = 0; e < 2; ++e) { const int id = 2 * wid + e, i = id >> 2, j = id & 3;
        const u32x2 qw = *(const u32x2*)(Qg + (size_t)i * D + lane * 4), kw = *(const u32x2*)(Kg + (size_t)j * D + lane * 4);
        float d = (bflo(qw.x) * bflo(kw.x) + bfhi(qw.x) * bfhi(kw.x)) + (bflo(qw.y) * bflo(kw.y) + bfhi(qw.y) * bfhi(kw.y));
        d = wave_sum(d); if (lane == 0) asc[id] = d; }
    __syncthreads();
    const int v4 = tid & 127, rg = tid >> 7;
    f32x4 vj[4];
#pragma unroll
    for (int j = 0; j < 4; ++j) { const u32x2 w = *(const u32x2*)(Vg + (size_t)j * VD + v4 * 4); vj[j] = (f32x4){bflo(w.x), bfhi(w.x), bflo(w.y), bfhi(w.y)}; }
    f32x4 oa[4];
#pragma unroll
    for (int i = 0; i < 4; ++i) oa[i] = (f32x4){0.f, 0.f, 0.f, 0.f};
    const float* S0 = p.in[3] + ((size_t)(s * 4 + h) * 256) * 512 + v4 * 4;
    float* S1 = p.out + OUT_RETS + ((size_t)(s * 4 + h) * 256) * 512 + v4 * 4;
#pragma unroll 8
    for (int it = 0; it < 64; ++it) { const int d = it * 4 + rg;
        const f32x4 s0 = __builtin_nontemporal_load((const f32x4*)(S0 + (size_t)d * 512));
        const f32x4 q4 = qs[d], k4 = kws[d];
        oa[0] += q4[0] * s0; oa[1] += q4[1] * s0; oa[2] += q4[2] * s0; oa[3] += q4[3] * s0;
        const f32x4 sn = g4 * s0 + ((k4[0] * vj[0] + k4[1] * vj[1]) + (k4[2] * vj[2] + k4[3] * vj[3]));
        __builtin_nontemporal_store(sn, (f32x4*)(S1 + (size_t)d * 512)); }
#pragma unroll
    for (int i = 0; i < 4; ++i) *(LAS f32x4*)(red + ((rg * 4 + i) * 512 + v4 * 4)) = oa[i];
    __syncthreads();
    { const int i = rg;
        f32x4 cr = (f32x4){0.f, 0.f, 0.f, 0.f};
#pragma unroll
        for (int r = 0; r < 4; ++r) cr += *(LAS f32x4*)(red + ((r * 4 + i) * 512 + v4 * 4));
        const float cwi = i == 0 ? g : (i == 1 ? g2 : (i == 2 ? g3 : g4));
        f32x4 o = cr * cwi;
        float dec = 1.f;
        for (int j = i; j >= 0; --j) { o += (asc[i * 4 + j] * dec) * vj[j]; dec *= g; }
        u32x2 w; w.x = cvt_pk_bf16(o[0], o[1]); w.y = cvt_pk_bf16(o[2], o[3]);
        *(u32x2*)(Og + (size_t)i * VD + v4 * 4) = w; }
}


constexpr int LDS_FQ = LDS_RET_END, LDS_FK = LDS_FQ + 4096, LDS_FA = LDS_FK + 4096;
static_assert(LDS_FA + 64 <= LDS_XB_ST, "fused retention LDS");
__device__ __forceinline__ void retention_fused(const Params& p, LAS unsigned char* lds, int unit) {
    const int tid = threadIdx.x, lane = tid & 63, wid = __builtin_amdgcn_readfirstlane(tid >> 6), fr = lane & 15, fq = lane >> 4;
    const int b = unit >> 5, h = (unit >> 3) & 3, vb = unit & 7;
    unsigned char* ws = p.ws;
    const bf16_t* Qg = (const bf16_t*)(ws + WS_Q) + (size_t)b * SEQ * D + h * 256;
    const bf16_t* Kg = (const bf16_t*)(ws + WS_K) + (size_t)b * SEQ * D + h * 256;
    const bf16_t* Vg = (const bf16_t*)(ws + WS_V) + (size_t)b * SEQ * VD + h * 512 + vb * 64;
    bf16_t* Og = (bf16_t*)(ws + WS_O) + (size_t)b * SEQ * VD + h * 512 + vb * 64;
    const float log2g = __log2f(1.0f - exp2f(-5.0f - (float)h));
    const float gC = exp2f(128.0f * log2g);
    f32x4 S[2][4];
#pragma unroll
    for (int mt = 0; mt < 2; ++mt)
#pragma unroll
        for (int nt = 0; nt < 4; ++nt) S[mt][nt] = (f32x4){0.f, 0.f, 0.f, 0.f};
    LAS unsigned char* Ks = lds + LDS_KS; LAS unsigned char* Vs = lds + LDS_VS; LAS unsigned char* Vw = lds + LDS_VW; LAS unsigned char* St = lds + LDS_ST;
    LAS f32x4* qs = (LAS f32x4*)(lds + LDS_FQ); LAS f32x4* kws = (LAS f32x4*)(lds + LDS_FK); LAS float* asc = (LAS float*)(lds + LDS_FA); LAS float* red = (LAS float*)(lds + 0);
    const int v4 = tid & 127, rg = tid >> 7;
    u32x2 vjp[4]; f32x4 oa[4];
    const float* S0 = nullptr; float* S1 = nullptr; bf16_t* Ogs = nullptr;
    float sg = 0.f, sg2 = 0.f, sg3 = 0.f, sg4 = 0.f;
#pragma unroll
    for (int i = 0; i < 4; ++i) { vjp[i] = (u32x2){0u, 0u}; oa[i] = (f32x4){0.f, 0.f, 0.f, 0.f}; }
    for (int c = 0; c < 16; ++c) {
        __syncthreads();
        if ((c & 7) == 0) {
            const int su = unit + (c >> 3) * 256, ss = su >> 2, sh = su & 3, t0 = TP + ss * 4;
            const bf16_t* Qs = (const bf16_t*)(ws + WS_Q) + (size_t)t0 * D + sh * 256;
            const bf16_t* Kq = (const bf16_t*)(ws + WS_K) + (size_t)t0 * D + sh * 256;
            const bf16_t* Vq = (const bf16_t*)(ws + WS_V) + (size_t)t0 * VD + sh * 512;
            Ogs = (bf16_t*)(ws + WS_O) + (size_t)t0 * VD + sh * 512;
            sg = 1.0f - exp2f(-5.0f - (float)sh); sg2 = sg * sg; sg3 = sg2 * sg; sg4 = sg2 * sg2;
            if (tid < 256) { const int d = tid;
                qs[d] = (f32x4){bf2f(Qs[d]), bf2f(Qs[D + d]), bf2f(Qs[2 * D + d]), bf2f(Qs[3 * D + d])};
                kws[d] = (f32x4){sg3 * bf2f(Kq[d]), sg2 * bf2f(Kq[D + d]), sg * bf2f(Kq[2 * D + d]), bf2f(Kq[3 * D + d])}; }
#pragma unroll
            for (int e = 0; e < 2; ++e) { const int id = 2 * wid + e, i = id >> 2, j = id & 3;
                const u32x2 qw = *(const u32x2*)(Qs + (size_t)i * D + lane * 4), kw = *(const u32x2*)(Kq + (size_t)j * D + lane * 4);
                float dd = (bflo(qw.x) * bflo(kw.x) + bfhi(qw.x) * bfhi(kw.x)) + (bflo(qw.y) * bflo(kw.y) + bfhi(qw.y) * bfhi(kw.y));
                dd = wave_sum(dd); if (lane == 0) asc[id] = dd; }
#pragma unroll
            for (int j = 0; j < 4; ++j) { vjp[j] = *(const u32x2*)(Vq + (size_t)j * VD + v4 * 4); oa[j] = (f32x4){0.f, 0.f, 0.f, 0.f}; }
            S0 = p.in[3] + ((size_t)(ss * 4 + sh) * 256) * 512 + v4 * 4;
            S1 = p.out + OUT_RETS + ((size_t)(ss * 4 + sh) * 256) * 512 + v4 * 4;
        }
#pragma unroll
        for (int mt = 0; mt < 2; ++mt)
#pragma unroll
            for (int nt = 0; nt < 4; ++nt) { u32x2 w; w.x = cvt_pk_bf16(S[mt][nt][0], S[mt][nt][1]); w.y = cvt_pk_bf16(S[mt][nt][2], S[mt][nt][3]);
                *(LAS u32x2*)(St + (nt * 16 + fr) * ST_STRIDE + (32 * wid + 16 * mt + fq * 4) * 2) = w; }
#pragma unroll
        for (int i = 0; i < 8; ++i) { const int id = tid + i * NTHREADS, row = id >> 5, cc = id & 31; *(LAS u32x4*)(Ks + row * KS_STRIDE + cc * 16) = *(const u32x4*)(Kg + (size_t)(c * 128 + row) * D + cc * 8); }
#pragma unroll
        for (int i = 0; i < 2; ++i) { const int id = tid + i * NTHREADS, row = id >> 3, cc = id & 7;
            const u32x4 v = *(const u32x4*)(Vg + (size_t)(c * 128 + row) * VD + cc * 8);
            *(LAS u32x4*)(Vs + row * VS_STRIDE + cc * 16) = v;
            const float sw = exp2f((float)(127 - row) * log2g);
            u32x4 w; w.x = cvt_pk_bf16(bflo(v.x) * sw, bfhi(v.x) * sw); w.y = cvt_pk_bf16(bflo(v.y) * sw, bfhi(v.y) * sw); w.z = cvt_pk_bf16(bflo(v.z) * sw, bfhi(v.z) * sw); w.w = cvt_pk_bf16(bflo(v.w) * sw, bfhi(v.w) * sw);
            *(LAS u32x4*)(Vw + row * VS_STRIDE + cc * 16) = w; }
        bf16x8 qf[8];
#pragma unroll
        for (int ks = 0; ks < 8; ++ks) qf[ks] = *(const bf16x8*)(Qg + (size_t)(c * 128 + 16 * wid + fr) * D + ks * 32 + fq * 8);
        __syncthreads();
        f32x4 s0v[4];
        const int dbase = (c & 7) * 32 + rg;
#define SAMPLE_ISSUE(hb) do { _Pragma("unroll") for (int i = 0; i < 4; ++i) s0v[i] = __builtin_nontemporal_load((const f32x4*)(S0 + (size_t)(dbase + 4 * ((hb) * 4 + i)) * 512)); } while (0)
#define SAMPLE_CONSUME(hb) do { const f32x4 vj0 = (f32x4){bflo(vjp[0].x), bfhi(vjp[0].x), bflo(vjp[0].y), bfhi(vjp[0].y)}, vj1 = (f32x4){bflo(vjp[1].x), bfhi(vjp[1].x), bflo(vjp[1].y), bfhi(vjp[1].y)}, \
            vj2 = (f32x4){bflo(vjp[2].x), bfhi(vjp[2].x), bflo(vjp[2].y), bfhi(vjp[2].y)}, vj3 = (f32x4){bflo(vjp[3].x), bfhi(vjp[3].x), bflo(vjp[3].y), bfhi(vjp[3].y)}; \
        _Pragma("unroll") for (int i = 0; i < 4; ++i) { const int d = dbase + 4 * ((hb) * 4 + i); \
            const f32x4 q4 = qs[d], k4 = kws[d], s0 = s0v[i]; \
            oa[0] += q4[0] * s0; oa[1] += q4[1] * s0; oa[2] += q4[2] * s0; oa[3] += q4[3] * s0; \
            const f32x4 sn = sg4 * s0 + ((k4[0] * vj0 + k4[1] * vj1) + (k4[2] * vj2 + k4[3] * vj3)); \
            __builtin_nontemporal_store(sn, (f32x4*)(S1 + (size_t)d * 512)); } } while (0)
        SAMPLE_ISSUE(0);
        f32x4 o[4];
#pragma unroll
        for (int nt = 0; nt < 4; ++nt) {
            o[nt] = (f32x4){0.f, 0.f, 0.f, 0.f};
#pragma unroll
            for (int ks = 0; ks < 8; ++ks) { const bf16x8 sf = *(const LAS bf16x8*)(St + (nt * 16 + fr) * ST_STRIDE + ks * 64 + fq * 16);
                o[nt] = __builtin_amdgcn_mfma_f32_16x16x32_bf16(qf[ks], sf, o[nt], 0, 0, 0); }
#pragma unroll
            for (int r = 0; r < 4; ++r) o[nt][r] *= exp2f((float)(16 * wid + fq * 4 + r + 1) * log2g);
        }
#pragma unroll 1
        for (int a = 0; 2 * a <= wid; ++a) {
            {
                f32x4 sc[2];
#pragma unroll
                for (int t = 0; t < 2; ++t) { const int jt = 2 * a + t;
                    sc[t] = (f32x4){0.f, 0.f, 0.f, 0.f};
                    if (jt <= wid) {
#pragma unroll
                        for (int ks = 0; ks < 8; ++ks) { const bf16x8 kf = *(const LAS bf16x8*)(Ks + (jt * 16 + fr) * KS_STRIDE + ks * 64 + fq * 16);
                            sc[t] = __builtin_amdgcn_mfma_f32_16x16x32_bf16(kf, qf[ks], sc[t], 0, 0, 0); }
#pragma unroll
                        for (int r = 0; r < 4; ++r) { const int dij = 16 * (wid - jt) + fr - fq * 4 - r;
                            sc[t][r] = dij >= 0 ? sc[t][r] * exp2f((float)dij * log2g) : 0.f; }
                    } }
                bf16x8 pa; { const u32x4 w = (u32x4){cvt_pk_bf16(sc[0][0], sc[0][1]), cvt_pk_bf16(sc[0][2], sc[0][3]), cvt_pk_bf16(sc[1][0], sc[1][1]), cvt_pk_bf16(sc[1][2], sc[1][3])}; pa = __builtin_bit_cast(bf16x8, w); }
#pragma unroll
                for (int nt = 0; nt < 4; ++nt) {
                    LAS const unsigned char* a0 = Vs + (32 * a + fq * 4 + (fr >> 2)) * VS_STRIDE + (nt * 16 + 4 * (fr & 3)) * 2;
                    const bf16x8 vf = tr_read2(a0, a0 + 16 * VS_STRIDE);
                    o[nt] = __builtin_amdgcn_mfma_f32_16x16x32_bf16(pa, vf, o[nt], 0, 0, 0); }
            }
        }
        SAMPLE_CONSUME(0);
        SAMPLE_ISSUE(1);
#pragma unroll
        for (int nt = 0; nt < 4; ++nt)
#pragma unroll
            for (int r = 0; r < 4; ++r) Og[(size_t)(c * 128 + 16 * wid + fq * 4 + r) * VD + nt * 16 + fr] = (bf16_t)(cvt_pk_bf16(o[nt][r], 0.f) & 0xffffu);
#pragma unroll
        for (int mt = 0; mt < 2; ++mt)
#pragma unroll
            for (int nt = 0; nt < 4; ++nt) S[mt][nt] = S[mt][nt] * gC;
#pragma unroll
        for (int ks = 0; ks < 4; ++ks) {
            bf16x8 af[2];
#pragma unroll
            for (int mt = 0; mt < 2; ++mt) { LAS const unsigned char* a0 = Ks + (ks * 32 + fq * 8 + (fr >> 2)) * KS_STRIDE + (32 * wid + 16 * mt + 4 * (fr & 3)) * 2;
                af[mt] = tr_read2(a0, a0 + 4 * KS_STRIDE); }
#pragma unroll
            for (int nt = 0; nt < 4; ++nt) { LAS const unsigned char* b0 = Vw + (ks * 32 + fq * 8 + (fr >> 2)) * VS_STRIDE + (nt * 16 + 4 * (fr & 3)) * 2;
                const bf16x8 bfr = tr_read2(b0, b0 + 4 * VS_STRIDE);
#pragma unroll
                for (int mt = 0; mt < 2; ++mt) S[mt][nt] = __builtin_amdgcn_mfma_f32_16x16x32_bf16(af[mt], bfr, S[mt][nt], 0, 0, 0); }
        }
        SAMPLE_CONSUME(1);
        if ((c & 7) == 7) {
            __syncthreads();
#pragma unroll
            for (int i = 0; i < 4; ++i) *(LAS f32x4*)(red + ((rg * 4 + i) * 512 + v4 * 4)) = oa[i];
            __syncthreads();
            const int i = rg;
            f32x4 cr = (f32x4){0.f, 0.f, 0.f, 0.f};
#pragma unroll
            for (int r = 0; r < 4; ++r) cr += *(LAS f32x4*)(red + ((r * 4 + i) * 512 + v4 * 4));
            const float cwi = i == 0 ? sg : (i == 1 ? sg2 : (i == 2 ? sg3 : sg4));
            f32x4 oo = cr * cwi;
            const f32x4 vsel0 = (f32x4){bflo(vjp[0].x), bfhi(vjp[0].x), bflo(vjp[0].y), bfhi(vjp[0].y)}, vsel1 = (f32x4){bflo(vjp[1].x), bfhi(vjp[1].x), bflo(vjp[1].y), bfhi(vjp[1].y)}, vsel2 = (f32x4){bflo(vjp[2].x), bfhi(vjp[2].x), bflo(vjp[2].y), bfhi(vjp[2].y)}, vsel3 = (f32x4){bflo(vjp[3].x), bfhi(vjp[3].x), bflo(vjp[3].y), bfhi(vjp[3].y)};
            if (i >= 0) oo += (asc[i * 4 + 0] * (i == 0 ? 1.f : (i == 1 ? sg : (i == 2 ? sg2 : sg3)))) * vsel0;
            if (i >= 1) oo += (asc[i * 4 + 1] * (i == 1 ? 1.f : (i == 2 ? sg : sg2))) * vsel1;
            if (i >= 2) oo += (asc[i * 4 + 2] * (i == 2 ? 1.f : sg)) * vsel2;
            if (i >= 3) oo += asc[i * 4 + 3] * vsel3;
            u32x2 w; w.x = cvt_pk_bf16(oo[0], oo[1]); w.y = cvt_pk_bf16(oo[2], oo[3]);
            *(u32x2*)(Ogs + (size_t)i * VD + v4 * 4) = w;
        }
    }
#undef SAMPLE_ISSUE
#undef SAMPLE_CONSUME
    float* So = p.out + OUT_RETP + ((size_t)(b * 4 + h) * 256) * 512 + vb * 64;
#pragma unroll
    for (int mt = 0; mt < 2; ++mt)
#pragma unroll
        for (int nt = 0; nt < 4; ++nt)
#pragma unroll
            for (int r = 0; r < 4; ++r) So[(size_t)(32 * wid + 16 * mt + fq * 4 + r) * 512 + nt * 16 + fr] = S[mt][nt][r];
}

__device__ __forceinline__ void phase_retention(const Params& p, LAS unsigned char* lds, int vcu, int G) {
    if (G == 256) { retention_fused(p, lds, vcu); __syncthreads(); return; }
    for (int unit = vcu; unit < 256; unit += G) retention_prompt_unit(p, lds, unit);
    for (int unit = vcu; unit < 512; unit += G) retention_sample_unit(p, lds, unit);
    __syncthreads();
}

__device__ __forceinline__ void phase_gnorm(const Params& p, int vcu, int G) {
    const int tid = threadIdx.x, lane = tid & 63, wave = tid >> 6;
    unsigned char* ws = p.ws;
    const bf16_t* O = (const bf16_t*)(ws + WS_O); const bf16_t* Gt = (const bf16_t*)(ws + WS_G); bf16_t* A8 = (bf16_t*)(ws + WS_A8);
    for (int t0 = (vcu * NWAVES + wave) * 2; t0 < T; t0 += G * NWAVES * 2) {
        u32x4 xo[8], xg[8];
#pragma unroll
        for (int i = 0; i < 8; ++i) { const size_t off = (size_t)(t0 + (i >> 2)) * VD + (i & 3) * 512 + lane * 8; xo[i] = __builtin_nontemporal_load((const u32x4*)(O + off)); xg[i] = __builtin_nontemporal_load((const u32x4*)(Gt + off)); }
#pragma unroll
        for (int i = 0; i < 8; ++i) { const size_t off = (size_t)(t0 + (i >> 2)) * VD + (i & 3) * 512 + lane * 8;
            float x[8], g[8]; unpack8(xo[i], x); unpack8(xg[i], g);
            const float s1 = ((x[0] + x[1]) + (x[2] + x[3])) + ((x[4] + x[5]) + (x[6] + x[7]));
            const float mu = wave_sum(s1) * (1.0f / 512.0f);
            float q = 0.f;
#pragma unroll
            for (int e = 0; e < 8; ++e) { x[e] -= mu; q += x[e] * x[e]; }
            const float rstd = rsqrtf(wave_sum(q) * (1.0f / 512.0f) + GN_EPS);
            f32x4 o[2];
#pragma unroll
            for (int e = 0; e < 8; ++e) o[e >> 2][e & 3] = g[e] * (x[e] * rstd);
            *(u32x4*)(A8 + off) = pack8(o[0], o[1]); }
    }
}

template <int NSLICE, bool FIRST> __device__ __forceinline__ void sample_finalize(const Params& p, int vcu, int G) {
    const int tid = threadIdx.x, lane = tid & 63, wave = tid >> 6;
    unsigned char* ws = p.ws;
    bf16_t* xb = (bf16_t*)(ws + WS_XB); float* part = (float*)(ws + WS_PART); const float* split = (const float*)(ws + WS_SPLIT);
    for (int row = TP + vcu * NWAVES + wave; row < T; row += G * NWAVES) {
        float ss = 0.f;
#pragma unroll
        for (int j = 0; j < 2; ++j) { const int col = j * 512 + lane * 8;
            f32x4 v0, v1;
            if (FIRST) { const float* xs = p.in[1] + (size_t)(row - TP) * D + col; v0 = *(const f32x4*)xs; v1 = *(const f32x4*)(xs + 4); }
            else { const u32x4 w = *(const u32x4*)(xb + (size_t)row * D + col); v0 = (f32x4){bflo(w.x), bfhi(w.x), bflo(w.y), bfhi(w.y)}; v1 = (f32x4){bflo(w.z), bfhi(w.z), bflo(w.w), bfhi(w.w)}; }
#pragma unroll
            for (int sl = 0; sl < NSLICE; ++sl) { const float* sp = split + ((size_t)sl * TS + (row - TP)) * D + col; v0 += *(const f32x4*)sp; v1 += *(const f32x4*)(sp + 4); }
            *(u32x4*)(xb + (size_t)row * D + col) = pack8(v0, v1);
            ss += ((v0[0] * v0[0] + v0[1] * v0[1]) + (v0[2] * v0[2] + v0[3] * v0[3])) + ((v1[0] * v1[0] + v1[1] * v1[1]) + (v1[2] * v1[2] + v1[3] * v1[3])); }
        ss = wave_sum(ss);
        if (lane < 16) part[(size_t)row * 16 + lane] = (lane == 0) ? ss : 0.f;
    }
}
__device__ __forceinline__ void phase_final(const Params& p, int vcu, int G) {
    const int tid = threadIdx.x, lane = tid & 63, wave = tid >> 6;
    unsigned char* ws = p.ws;
    const float* gn = p.in[15]; const float* split = (const float*)(ws + WS_SPLIT); const bf16_t* xbq = (const bf16_t*)(ws + WS_XB);
    float* y = p.out + OUT_Y;
    f32x4 gg[4];
#pragma unroll
    for (int j = 0; j < 4; ++j) gg[j] = *(const f32x4*)(gn + j * 256 + lane * 4);
    for (int r0 = (vcu * NWAVES + wave) * 2; r0 < T; r0 += G * NWAVES * 2) {
        f32x4 v[2][4];
#pragma unroll
        for (int k = 0; k < 2; ++k)
#pragma unroll
            for (int j = 0; j < 4; ++j) { const u32x2 w = __builtin_nontemporal_load((const u32x2*)(xbq + (size_t)(r0 + k) * D + j * 256 + lane * 4)); v[k][j] = (f32x4){bflo(w.x), bfhi(w.x), bflo(w.y), bfhi(w.y)}; }
        if (r0 >= TP) {
#pragma unroll
            for (int k = 0; k < 2; ++k)
#pragma unroll
                for (int j = 0; j < 4; ++j)
#pragma unroll
                    for (int sl = 0; sl < 11; ++sl) v[k][j] += *(const f32x4*)(split + ((size_t)sl * TS + (r0 + k - TP)) * D + j * 256 + lane * 4);
        }
#pragma unroll
        for (int k = 0; k < 2; ++k) { float ss = 0.f;
#pragma unroll
            for (int j = 0; j < 4; ++j) ss += (v[k][j][0] * v[k][j][0] + v[k][j][1] * v[k][j][1]) + (v[k][j][2] * v[k][j][2] + v[k][j][3] * v[k][j][3]);
            const float rs = rsqrtf(wave_sum(ss) * (1.0f / D) + RMS_EPS);
#pragma unroll
            for (int j = 0; j < 4; ++j) __builtin_nontemporal_store(v[k][j] * rs * gg[j], (f32x4*)(y + (size_t)(r0 + k) * D + j * 256 + lane * 4)); }
    }
}

constexpr int NPHASES = 13;
__global__ void __launch_bounds__(NTHREADS, 2) mega_fwd(Params p) {
    extern __shared__ __attribute__((aligned(16))) unsigned char lds_raw[];
    LAS unsigned char* lds = (LAS unsigned char*)lds_raw;
    cg::grid_group grid = cg::this_grid();
    const int G = gridDim.x, bx = blockIdx.x;
    const int vcu = (G % 8 == 0) ? (bx % 8) * (G / 8) + bx / 8 : bx;
    unsigned char* ws = p.ws;
    const int lo = p.ph_lo, hi = p.ph_hi;
#define IN(k) (lo <= (k) && (k) < hi)
#define SEAM(k) do { if (IN(k) && IN((k) + 1)) { if (lo < 0) grid.sync(); else xcd_barrier(bar); } } while (0)
    if (threadIdx.x < 2) ((LAS unsigned*)(lds + LDS_XB_ST))[threadIdx.x] = 0u;
    __syncthreads();
    XcdBarrier bar; bar.bar = (unsigned*)(ws + WS_BAR); bar.x = 0; bar.st = nullptr;
    if (hi - lo > 1) bar = xcd_barrier_post((unsigned*)(ws + WS_BAR), (volatile LAS unsigned*)(lds + LDS_XB_ST));
    const float* part = (const float*)(ws + WS_PART);
    bf16_t* xb = (bf16_t*)(ws + WS_XB); float* xres = (float*)(ws + WS_XRES);

    if (IN(0)) { phase_prologue(p, lds, vcu, G); } SEAM(0);
    if (IN(1)) {
        pg8::Gemm g{xb, (const bf16_t*)(ws + WS_WCIN), T, 3072, 1024}; pg8::StaticOrder S; S.init(T, 3072, G, bx, g.K);
        EpiConvIn E{part, (bf16_t*)(ws + WS_BB), (bf16_t*)(ws + WS_UB), p.out + OUT_CONVP, p.out + OUT_CONVS};
        pg8::gemm_phase<EpiConvIn, pg8::StaticOrder, true, true>(lds, g, S, E);
        idle_slot_transposes(p, lds, 1, S.nwg, G, bx);
    } SEAM(1);
    if (IN(2)) { phase_conv(p, vcu, G); } SEAM(2);
    if (IN(3)) {
        pg8::Gemm g{(const bf16_t*)(ws + WS_A2), (const bf16_t*)(ws + WS_WCOUT), T, 1024, 1024}; pg8::SplitOrder S; S.init(TP, 1024, G, bx, g.K);
        EpiResid<1> E{p.in[0], p.in[1], xres, xb, (float*)(ws + WS_PART), (float*)(ws + WS_SPLIT)};
        pg8::gemm_phase<EpiResid<1>, pg8::SplitOrder, true, true>(lds, g, S, E);
    } SEAM(3);
    if (IN(4)) {
        sample_finalize<4, false>(p, vcu, G); xcd_barrier(bar);
        pg8::Gemm g{xb, (const bf16_t*)(ws + WS_WGU0), T, 5632, 1024}; pg8::StaticOrder S; S.init(T, 5632, G, bx, g.K);
        EpiSwiGLU E{part, (bf16_t*)(ws + WS_HFF)};
        pg8::gemm_phase<EpiSwiGLU, pg8::StaticOrder, true, true>(lds, g, S, E);
        idle_slot_transposes(p, lds, 2, S.nwg, G, bx);
    } SEAM(4);
    if (IN(5)) {
        pg8::Gemm g{(const bf16_t*)(ws + WS_HFF), (const bf16_t*)(ws + WS_WD0), T, 1024, DFF}; pg8::SplitOrder S; S.init(TP, 1024, G, bx, g.K);
        EpiResid<1> E{nullptr, nullptr, xres, xb, (float*)(ws + WS_PART), (float*)(ws + WS_SPLIT)};
        pg8::gemm_phase<EpiResid<1>, pg8::SplitOrder, true, true>(lds, g, S, E);
    } SEAM(5);
    if (IN(6)) {
        sample_finalize<11, false>(p, vcu, G); xcd_barrier(bar);
        pg8::Gemm g{xb, (const bf16_t*)(ws + WS_WRIN), T, RIN, 1024}; pg8::StaticOrder S; S.init(T, RIN, G, bx, g.K);
        EpiRetIn E{part, (const float*)(ws + WS_ROPE), (bf16_t*)(ws + WS_Q), (bf16_t*)(ws + WS_K), (bf16_t*)(ws + WS_V), (bf16_t*)(ws + WS_G)};
        pg8::gemm_phase<EpiRetIn, pg8::StaticOrder, true, true>(lds, g, S, E);
        idle_slot_transposes(p, lds, 3, S.nwg, G, bx);
    } SEAM(6);
    if (IN(7)) { phase_retention(p, lds, vcu, G); } SEAM(7);
    if (IN(8)) { phase_gnorm(p, vcu, G); } SEAM(8);
    if (IN(9)) {
        pg8::Gemm g{(const bf16_t*)(ws + WS_A8), (const bf16_t*)(ws + WS_WROUT), T, 1024, VD}; pg8::SplitOrder S; S.init(TP, 1024, G, bx, g.K);
        EpiResid<1> E{nullptr, nullptr, xres, xb, (float*)(ws + WS_PART), (float*)(ws + WS_SPLIT)};
        pg8::gemm_phase<EpiResid<1>, pg8::SplitOrder, true, true>(lds, g, S, E);
    } SEAM(9);
    if (IN(10)) {
        sample_finalize<8, false>(p, vcu, G); xcd_barrier(bar);
        pg8::Gemm g{xb, (const bf16_t*)(ws + WS_WGU1), T, 5632, 1024}; pg8::StaticOrder S; S.init(T, 5632, G, bx, g.K);
        EpiSwiGLU E{part, (bf16_t*)(ws + WS_HFF)};
        pg8::gemm_phase<EpiSwiGLU, pg8::StaticOrder, true, true>(lds, g, S, E);
    } SEAM(10);
    if (IN(11)) {
        pg8::Gemm g{(const bf16_t*)(ws + WS_HFF), (const bf16_t*)(ws + WS_WD1), T, 1024, DFF}; pg8::SplitOrder S; S.init(TP, 1024, G, bx, g.K);
        EpiResid<2> E{nullptr, nullptr, xres, xb, (float*)(ws + WS_PART), (float*)(ws + WS_SPLIT)};
        pg8::gemm_phase<EpiResid<2>, pg8::SplitOrder, true, true>(lds, g, S, E);
    } SEAM(11);
    if (IN(12)) { phase_final(p, vcu, G); }
#undef IN
#undef SEAM
}

extern "C" void kernel_launch(void* const* d_in, const int* in_sizes, int n_in, void* d_out, int out_size, void* d_ws, size_t ws_size, hipStream_t stream) {
    static int grid = 0;
    if (grid == 0) {
        if (n_in != 16 || (size_t)out_size != OUT_END || ws_size < WS_END) { fprintf(stderr, "kernel_launch: unexpected shapes: n_in %d out %d ws %zu (need %zu)\n", n_in, out_size, ws_size, (size_t)WS_END); grid = -1; return; }
        int dev = 0, cus = 0, per_cu = 0;
        (void)hipGetDevice(&dev); (void)hipDeviceGetAttribute(&cus, hipDeviceAttributeMultiprocessorCount, dev);
        if (hipFuncSetAttribute((const void*)mega_fwd, hipFuncAttributeMaxDynamicSharedMemorySize, LDS_BYTES) != hipSuccess) { fprintf(stderr, "kernel_launch: hipFuncSetAttribute failed\n"); grid = -1; return; }
        if (hipOccupancyMaxActiveBlocksPerMultiprocessor(&per_cu, (const void*)mega_fwd, NTHREADS, LDS_BYTES) != hipSuccess || per_cu < 1) { fprintf(stderr, "kernel_launch: occupancy query failed (%d)\n", per_cu); (void)hipGetLastError(); per_cu = 1; }
        grid = cus * per_cu;
        if (grid % 8 != 0 || grid <= 0) grid = cus;
    }
    if (grid < 0) return;
    if (hipMemsetAsync((unsigned char*)d_ws + WS_BAR, 0, BAR_BYTES, stream) != hipSuccess) { fprintf(stderr, "memset failed\n"); return; }
    Params p{};
    for (int i = 0; i < 16; ++i) p.in[i] = (const float*)d_in[i];
    p.out = (float*)d_out; p.ws = (unsigned char*)d_ws;
#if MK_N_LAUNCHES == 1
    p.ph_lo = 0; p.ph_hi = NPHASES;
    void* args[] = {&p};
    hipError_t e = hipLaunchCooperativeKernel((const void*)mega_fwd, dim3(grid), dim3(NTHREADS), args, LDS_BYTES, stream);
    if (e != hipSuccess) fprintf(stderr, "cooperative launch failed: %s (grid %d)\n", hipGetErrorString(e), grid);
#else
    for (int ph = 0; ph < NPHASES; ++ph) { p.ph_lo = ph; p.ph_hi = ph + 1; hipLaunchKernelGGL(mega_fwd, dim3(grid), dim3(NTHREADS), LDS_BYTES, stream, p); }
#endif
}
```

```cpp
#include <hip/hip_runtime.h>
#include <hip/hip_cooperative_groups.h>
#include <cstdio>
#include <cstdint>
namespace cg = cooperative_groups;

#ifndef MK_N_LAUNCHES
#define MK_N_LAUNCHES 1
#endif

namespace pg8 {
#define PG8_LAS __attribute__((address_space(3)))
typedef unsigned short bf16_t;
typedef short bf16x8 __attribute__((ext_vector_type(8)));
typedef float f32x4 __attribute__((ext_vector_type(4)));
typedef unsigned u32x4 __attribute__((ext_vector_type(4)));
constexpr int BM = 256, BK = 64, HALF = 128, HTB = HALF * BK * 2, STAGE_BYTES = 8 * HTB, NXCD = 8, WGM = 8;

__host__ __device__ __forceinline__ int lds_byte(int r, int c) { const int st = (r >> 4) * 2 + (c >> 5), rr = r & 15, cc = c & 31, ob = rr * 64 + cc * 2; return st * 1024 + (ob ^ (((ob >> 9) & 1) << 5)); }
__host__ __device__ __forceinline__ void stage_rc(int b, int& R, int& C) { const int st = b / 1024, sb = b % 1024, swz = sb ^ (((sb >> 9) & 1) << 5); R = (st >> 1) * 16 + swz / 64; C = (st & 1) * 32 + (swz % 64) / 2; }
__host__ __device__ __forceinline__ int perm32(int rho) { const int n = rho >> 4, i = rho & 15; return 8 * (i >> 2) + 4 * n + (i & 3); }

struct Unit { int pm, pn, kt0, nt; };
struct Gemm { const bf16_t* A; const bf16_t* Bt; int M, N, K; };

struct StaticOrder {
    int nM, nN, nwg, G, c, ntk;
    __host__ __device__ void init(int M, int N, int G_, int c_, int K) { nM = M / BM; nN = N / BM; nwg = nM * nN; G = G_; c = c_; ntk = K / BK; }
    __host__ __device__ bool next(int i, Unit& u) const {
        const long L = (long)i * G + c; if (L >= nwg) return false;
        int wgid = (int)L; { const int q = nwg / NXCD, r = nwg % NXCD, xcd = wgid % NXCD, off = wgid / NXCD; wgid = (xcd < r ? xcd * (q + 1) : r * (q + 1) + (xcd - r) * q) + off; }
        const int nig = WGM * nN, gid = wgid / nig, fm = gid * WGM, gsz = (nM - fm) < WGM ? (nM - fm) : WGM;
        u.pm = fm + ((wgid % nig) % gsz); u.pn = (wgid % nig) / gsz; u.kt0 = 0; u.nt = ntk; return true;
    }
    __device__ __forceinline__ void a_ready(const Unit&) const {}
    __device__ __forceinline__ void done(const Unit&) const {}
};
struct SplitOrder {
    StaticOrder P; int nslice, G, c;
    __host__ __device__ void init(int Mp, int N, int G_, int c_, int K) { P.init(Mp, N, G_, c_, K); nslice = (K / BK) / 4; G = G_; c = c_; }
    __host__ __device__ bool next(int i, Unit& u) const {
        const long L = (long)i * G + c;
        if (L < P.nwg) return P.next(i, u);
        const int j = (int)(L - P.nwg), nS = 2 * P.nN;
        if (j >= nS * nslice) return false;
        const int su = j % nS, sl = j / nS;
        u.pm = P.nM + su / P.nN; u.pn = su % P.nN; u.kt0 = sl * 4; u.nt = 4; return true;
    }
    __device__ __forceinline__ void a_ready(const Unit&) const {}
    __device__ __forceinline__ void done(const Unit&) const {}
};
typedef __bf16 bf16x2_cv __attribute__((ext_vector_type(2)));
typedef float f32x2_cv __attribute__((ext_vector_type(2)));
__device__ __forceinline__ unsigned cvt_pk_bf16(float lo, float hi) { const bf16x2_cv v = __builtin_convertvector((f32x2_cv){lo, hi}, bf16x2_cv); return __builtin_bit_cast(unsigned, v); }

template <class Epi, class Sched, bool ALIGN_EPI = false, bool SP2 = false>
__device__ __forceinline__ void gemm_phase(PG8_LAS unsigned char* lds, const Gemm g, const Sched& S, const Epi& E) {
    const int tid = threadIdx.x, wid = __builtin_amdgcn_readfirstlane(tid >> 6), lane = tid & 63, wr = wid >> 2, wc = wid & 3, fr = lane & 15, fq = lane >> 4;
    const int K = g.K;
    unsigned voffA[2], voffB[2];
#pragma unroll
    for (int i = 0; i < 2; ++i) { int R, C; stage_rc(tid * 16 + i * 8192, R, C); const int Rb = Epi::PERM ? ((R & ~31) + perm32(R & 31)) : R;
        voffA[i] = (unsigned)(R * K + C) * 2u; voffB[i] = (unsigned)(Rb * K + C) * 2u; }
    const size_t kstep = (size_t)(BK * 2);
    const size_t hstep = (size_t)HALF * K * 2;
    const size_t tstep = 2 * hstep;
    const unsigned ldsw = (unsigned)wid * 1024u;
    const int aoff = lds_byte(wr * 64 + fr, fq * 8), boff = lds_byte(wc * 32 + fr, fq * 8);
#define PG8_SA(b, h) (((b) * 2 + (h)) * HTB)
#define PG8_SB(b, h) ((4 + (b) * 2 + (h)) * HTB)
#define PG8_STAGE(bufoff, gbase, voff) do { _Pragma("unroll") for (int _i = 0; _i < 2; ++_i) \
        __builtin_amdgcn_global_load_lds((const unsigned*)((const char*)(gbase) + (voff)[_i]), (PG8_LAS unsigned*)(lds + (bufoff) + ldsw + _i * 8192), 16, 0, 0); } while (0)
#define PG8_LDA(dst, b, h) do { _Pragma("unroll") for (int m = 0; m < 4; ++m) _Pragma("unroll") for (int k = 0; k < 2; ++k) dst[m][k] = *(const PG8_LAS bf16x8*)(lds + PG8_SA(b, h) + aoff + m * 2048 + k * 1024); } while (0)
#define PG8_LDB(dst, b, h) do { _Pragma("unroll") for (int n = 0; n < 2; ++n) _Pragma("unroll") for (int k = 0; k < 2; ++k) dst[n][k] = *(const PG8_LAS bf16x8*)(lds + PG8_SB(b, h) + boff + n * 2048 + k * 1024); } while (0)
#define PG8_MMA(ai, bj, At, Bt) do { __builtin_amdgcn_s_setprio(1); _Pragma("unroll") for (int m = 0; m < 4; ++m) _Pragma("unroll") for (int n = 0; n < 2; ++n) _Pragma("unroll") for (int k = 0; k < 2; ++k) \
        acc[ai][bj][m][n] = __builtin_amdgcn_mfma_f32_16x16x32_bf16(Bt[n][k], At[m][k], acc[ai][bj][m][n], 0, 0, 0); __builtin_amdgcn_s_setprio(0); } while (0)
#define PG8_WAIT_V(n) asm volatile("s_waitcnt vmcnt(" #n ")" ::: "memory")
#define PG8_WAIT_L(n) asm volatile("s_waitcnt lgkmcnt(" #n ")" ::: "memory")
#define PG8_BAR __builtin_amdgcn_s_barrier()
#define PG8_SCHED __builtin_amdgcn_sched_barrier(0)
    Unit cur, nxt; int ui = 0;
    if (!S.next(0, cur)) return;
    f32x4 acc[2][2][4][2];
#pragma unroll
    for (int a = 0; a < 2; ++a)
#pragma unroll
        for (int b = 0; b < 2; ++b)
#pragma unroll
            for (int m = 0; m < 4; ++m)
#pragma unroll
                for (int n = 0; n < 2; ++n) acc[a][b][m][n] = (f32x4){0.f, 0.f, 0.f, 0.f};
    bf16x8 At[4][2], B0[2][2], B1[2][2];
    const char* cA = (const char*)g.A + (size_t)cur.pm * tstep + (size_t)cur.kt0 * kstep; const char* cB = (const char*)g.Bt + (size_t)cur.pn * tstep + (size_t)cur.kt0 * kstep;
    S.a_ready(cur);
    if constexpr (SP2) {
        PG8_STAGE(PG8_SB(0, 0), cB, voffB); PG8_STAGE(PG8_SB(0, 1), cB + hstep, voffB); PG8_STAGE(PG8_SA(0, 0), cA, voffA); PG8_STAGE(PG8_SA(0, 1), cA + hstep, voffA);
        if (wr == 1) PG8_BAR;
        PG8_WAIT_V(2); PG8_BAR;
        PG8_STAGE(PG8_SB(1, 0), cB + kstep, voffB); PG8_STAGE(PG8_SA(1, 0), cA + kstep, voffA); PG8_STAGE(PG8_SB(1, 1), cB + hstep + kstep, voffB);
        PG8_WAIT_V(6); PG8_BAR;
    } else {
        PG8_STAGE(PG8_SB(0, 0), cB, voffB); PG8_STAGE(PG8_SA(0, 0), cA, voffA); PG8_STAGE(PG8_SB(0, 1), cB + hstep, voffB); PG8_STAGE(PG8_SA(0, 1), cA + hstep, voffA);
        if (wr == 1) PG8_BAR;
        PG8_WAIT_V(4); PG8_BAR;
        PG8_STAGE(PG8_SB(1, 0), cB + kstep, voffB); PG8_STAGE(PG8_SA(1, 0), cA + kstep, voffA); PG8_STAGE(PG8_SB(1, 1), cB + hstep + kstep, voffB);
        PG8_WAIT_V(6); PG8_BAR;
    }
    for (;;) {
        const bool has_next = S.next(ui + 1, nxt);
        const char* nA = has_next ? (const char*)g.A + (size_t)nxt.pm * tstep + (size_t)nxt.kt0 * kstep : cA; const char* nB = has_next ? (const char*)g.Bt + (size_t)nxt.pn * tstep + (size_t)nxt.kt0 * kstep : cB;
        const int nt = cur.nt;
        for (int t = 0; t < nt; t += 2) {
            const bool last = (t == nt - 2);
            const char* a1 = cA + (size_t)(t + 1) * kstep;
            const char* a2 = last ? nA : cA + (size_t)(t + 2) * kstep; const char* b2 = last ? nB : cB + (size_t)(t + 2) * kstep;
            const char* a3 = a2 + kstep; const char* b3 = b2 + kstep;
            if (last && has_next) S.a_ready(nxt);
            if constexpr (SP2) {
            PG8_LDB(B0, 0, 0); PG8_LDB(B1, 0, 1); PG8_SCHED; PG8_LDA(At, 0, 0); PG8_STAGE(PG8_SA(1, 1), a1 + hstep, voffA);
            PG8_WAIT_V(8); PG8_WAIT_L(0); PG8_BAR; PG8_MMA(0, 0, At, B0); PG8_MMA(0, 1, At, B1); PG8_BAR; PG8_SCHED;
            PG8_LDA(At, 0, 1); PG8_STAGE(PG8_SB(0, 0), b2, voffB); PG8_STAGE(PG8_SB(0, 1), b2 + hstep, voffB); PG8_STAGE(PG8_SA(0, 0), a2, voffA);
            PG8_WAIT_V(8); PG8_WAIT_L(0); PG8_BAR; PG8_MMA(1, 0, At, B0); PG8_MMA(1, 1, At, B1); PG8_BAR; PG8_SCHED;
            PG8_LDB(B0, 1, 0); PG8_LDB(B1, 1, 1); PG8_SCHED; PG8_LDA(At, 1, 0); PG8_STAGE(PG8_SA(0, 1), a2 + hstep, voffA);
            PG8_WAIT_V(8); PG8_WAIT_L(0); PG8_BAR; PG8_MMA(0, 0, At, B0); PG8_MMA(0, 1, At, B1); PG8_BAR; PG8_SCHED;
            PG8_LDA(At, 1, 1); PG8_STAGE(PG8_SB(1, 0), b3, voffB); PG8_STAGE(PG8_SB(1, 1), b3 + hstep, voffB); PG8_STAGE(PG8_SA(1, 0), a3, voffA);
            PG8_WAIT_V(8); PG8_WAIT_L(0); PG8_BAR; PG8_MMA(1, 0, At, B0); PG8_MMA(1, 1, At, B1); PG8_BAR; PG8_SCHED;
            } else {
            PG8_LDB(B0, 0, 0); PG8_SCHED; PG8_LDA(At, 0, 0); PG8_STAGE(PG8_SA(1, 1), a1 + hstep, voffA);
            PG8_WAIT_L(8); PG8_BAR; PG8_WAIT_L(0); PG8_MMA(0, 0, At, B0); PG8_BAR; PG8_SCHED;
            PG8_LDB(B1, 0, 1); PG8_STAGE(PG8_SB(0, 0), b2, voffB);
            PG8_BAR; PG8_WAIT_L(0); PG8_MMA(0, 1, At, B1); PG8_BAR;
            PG8_LDA(At, 0, 1); PG8_STAGE(PG8_SA(0, 0), a2, voffA);
            PG8_BAR; PG8_WAIT_L(0); PG8_MMA(1, 0, At, B0); PG8_BAR; PG8_SCHED;
            PG8_STAGE(PG8_SB(0, 1), b2 + hstep, voffB);
            PG8_WAIT_V(6); PG8_BAR; PG8_MMA(1, 1, At, B1); PG8_BAR;
            PG8_LDB(B0, 1, 0); PG8_SCHED; PG8_LDA(At, 1, 0); PG8_STAGE(PG8_SA(0, 1), a2 + hstep, voffA);
            PG8_WAIT_L(8); PG8_BAR; PG8_WAIT_L(0); PG8_MMA(0, 0, At, B0); PG8_BAR; PG8_SCHED;
            PG8_LDB(B1, 1, 1); PG8_STAGE(PG8_SB(1, 0), b3, voffB);
            PG8_BAR; PG8_WAIT_L(0); PG8_MMA(0, 1, At, B1); PG8_BAR;
            PG8_LDA(At, 1, 1); PG8_STAGE(PG8_SA(1, 0), a3, voffA);
            PG8_BAR; PG8_WAIT_L(0); PG8_MMA(1, 0, At, B0); PG8_BAR; PG8_SCHED;
            PG8_STAGE(PG8_SB(1, 1), b3 + hstep, voffB);
            PG8_WAIT_V(6); PG8_BAR; PG8_MMA(1, 1, At, B1); PG8_BAR;
            }
        }
        if constexpr (ALIGN_EPI) { if (wr == 0) PG8_BAR; }
        if constexpr (!Epi::AFTER_DRAIN) { E(acc, cur, wr, wc, fr, fq); S.done(cur); }
        if (!has_next) break;
#pragma unroll
        for (int a = 0; a < 2; ++a)
#pragma unroll
            for (int b = 0; b < 2; ++b)
#pragma unroll
                for (int m = 0; m < 4; ++m)
#pragma unroll
                    for (int n = 0; n < 2; ++n) acc[a][b][m][n] = (f32x4){0.f, 0.f, 0.f, 0.f};
        cur = nxt; cA = nA; cB = nB; ++ui;
        if constexpr (ALIGN_EPI) { if (wr == 1) PG8_BAR; }
    }
    PG8_WAIT_V(0);
    if constexpr (!ALIGN_EPI) { if (wr == 0) PG8_BAR; }
    PG8_BAR;
    if constexpr (Epi::AFTER_DRAIN) { E.fused(acc, cur, wr, wc, fr, fq, lds, wid, lane); S.done(cur); }
#undef PG8_SA
#undef PG8_SB
#undef PG8_STAGE
#undef PG8_LDA
#undef PG8_LDB
#undef PG8_MMA
#undef PG8_WAIT_V
#undef PG8_WAIT_L
#undef PG8_BAR
#undef PG8_SCHED
}
}

#define LAS __attribute__((address_space(3)))
typedef unsigned short bf16_t;
typedef short bf16x8 __attribute__((ext_vector_type(8)));
typedef short s16x4 __attribute__((ext_vector_type(4)));
typedef float f32x4 __attribute__((ext_vector_type(4)));
typedef float f32x2 __attribute__((ext_vector_type(2)));
typedef unsigned u32x4 __attribute__((ext_vector_type(4)));
typedef unsigned u32x2 __attribute__((ext_vector_type(2)));
using pg8::cvt_pk_bf16;

constexpr int NWAVES = 8, NTHREADS = 512;
constexpr int LDS_BYTES = 147456;
constexpr int D = 1024, TP = 16384, TS = 512, T = TP + TS, SEQ = 2048, DFF = 2816, RIN = 6144, VD = 2048;
constexpr int NROPE = SEQ + 4;
constexpr float RMS_EPS = 1e-6f, GN_EPS = 1e-6f;
constexpr size_t OUT_Y = 0, OUT_CONVP = (size_t)T * D, OUT_CONVS = OUT_CONVP + 8 * 2 * D, OUT_RETP = OUT_CONVS + 128 * 2 * D,
                 OUT_RETS = OUT_RETP + (size_t)8 * 4 * 256 * 512, OUT_END = OUT_RETS + (size_t)128 * 4 * 256 * 512;
constexpr size_t al256(size_t x) { return (x + 255) & ~(size_t)255; }
constexpr size_t WS_WCIN = 0;
constexpr size_t WS_WCOUT = WS_WCIN + (size_t)3072 * 1024 * 2;
constexpr size_t WS_WGU0 = WS_WCOUT + (size_t)1024 * 1024 * 2;
constexpr size_t WS_WGU1 = WS_WGU0 + (size_t)5632 * 1024 * 2;
constexpr size_t WS_WD0 = WS_WGU1 + (size_t)5632 * 1024 * 2;
constexpr size_t WS_WD1 = WS_WD0 + (size_t)1024 * 2816 * 2;
constexpr size_t WS_WRIN = WS_WD1 + (size_t)1024 * 2816 * 2;
constexpr size_t WS_WROUT = WS_WRIN + (size_t)6144 * 1024 * 2;
constexpr size_t WS_ROPE = WS_WROUT + (size_t)1024 * 2048 * 2;
constexpr size_t WS_PART = al256(WS_ROPE + (size_t)NROPE * 128 * 8);
constexpr size_t WS_XB = al256(WS_PART + (size_t)T * 16 * 4);
constexpr size_t WS_XRES = WS_XB + (size_t)T * D * 2;
constexpr size_t WS_R = WS_XRES + (size_t)T * D * 4;
constexpr size_t SZ_TD = (size_t)T * D * 2, SZ_TV = (size_t)T * VD * 2;
constexpr size_t WS_BB = WS_R, WS_UB = WS_R + SZ_TD, WS_A2 = WS_R + 2 * SZ_TD;
constexpr size_t WS_HFF = WS_R;
constexpr size_t WS_Q = WS_R, WS_K = WS_Q + SZ_TD, WS_V = WS_K + SZ_TD, WS_G = WS_V + SZ_TV, WS_O = WS_G + SZ_TV, WS_A8 = WS_O + SZ_TV;
constexpr size_t WS_BAR = al256(WS_A8 + SZ_TV), BAR_BYTES = 16384;
constexpr size_t WS_SPLIT = WS_BAR + BAR_BYTES;
constexpr size_t WS_END = WS_SPLIT + (size_t)11 * TS * D * 4;
constexpr int LDS_XB_ST = LDS_BYTES - 64;
static_assert((size_t)T * DFF * 2 <= WS_END - WS_R, "hff fits");


#define XB_TMO      128
#define XB_XCNT(j)  (256  + 64 * (j))
#define XB_XSUB(j)  (1280 + 64 * (j))
#define XB_XGEN(j)  (2304 + 64 * (j))
#define XB_TOP      3328
#define XB_TOPGEN   3392
#define XCD_BAR_WORDS 3456
#define XB_SPIN_CAP (1u << 18)

__device__ __forceinline__ unsigned xb_ld(unsigned* p)              { return __hip_atomic_load(p, __ATOMIC_RELAXED, __HIP_MEMORY_SCOPE_AGENT); }
__device__ __forceinline__ unsigned xb_add(unsigned* p, unsigned v) { return __hip_atomic_fetch_add(p, v, __ATOMIC_RELAXED, __HIP_MEMORY_SCOPE_AGENT); }
__device__ __forceinline__ unsigned xb_xcc_id() { return (unsigned)__builtin_amdgcn_s_getreg((3 << 11) | 20) & 0xFu; }
#define XB_SPIN(cond, bar) do { unsigned _sp = 0; while (cond) { __builtin_amdgcn_s_sleep(1); \
    if ((++_sp & 255u) == 0u) { if (xb_ld(&(bar)[XB_TMO])) break; if (_sp > XB_SPIN_CAP) { atomicAdd(&(bar)[XB_TMO], 1u); break; } } } } while (0)

struct XcdBarrier {
    unsigned* bar; unsigned x;
    volatile LAS unsigned* st;
};

__device__ __forceinline__ XcdBarrier xcd_barrier_post(unsigned* bar, volatile LAS unsigned* st) {
    XcdBarrier b; b.bar = bar; b.x = xb_xcc_id(); b.st = st;
    if (threadIdx.x == 0) (void)xb_add(&bar[XB_XCNT(b.x)], 1u);
    return b;
}
__device__ __forceinline__ void xcd_barrier_complete(unsigned* bar, unsigned x, unsigned& nloc, unsigned& nx) {
    const unsigned G = gridDim.x * gridDim.y * gridDim.z;
    unsigned sum, cnt, mine, sp = 0u;
    for (;;) {
        sum = 0u; cnt = 0u; mine = 0u;
#pragma unroll
        for (unsigned j = 0; j < 16; ++j) { const unsigned c = xb_ld(&bar[XB_XCNT(j)]); sum += c; cnt += (c > 0u) ? 1u : 0u; mine = (j == x) ? c : mine; }
        if (sum == G) break;
        __builtin_amdgcn_s_sleep(1);
        if ((++sp & 255u) == 0u) { if (xb_ld(&bar[XB_TMO])) break; if (sp > XB_SPIN_CAP) { atomicAdd(&bar[XB_TMO], 1u); break; } }
    }
    nloc = mine > 0u ? mine : 1u; nx = cnt > 0u ? cnt : 1u;
}

__device__ __forceinline__ void xcd_barrier(const XcdBarrier& b) {
    asm volatile("s_waitcnt vmcnt(0)" ::: "memory");
    __syncthreads();
    if (threadIdx.x == 0) {
        unsigned* bar = b.bar;
        __builtin_amdgcn_s_waitcnt(0);
        unsigned nloc = b.st[0], nx = b.st[1];
        if (nloc == 0u) { xcd_barrier_complete(bar, b.x, nloc, nx); b.st[0] = nloc; b.st[1] = nx; }
        const unsigned old = xb_add(&bar[XB_XSUB(b.x)], 1u);
        const unsigned gen = old / nloc;
        if (old + 1u == (gen + 1u) * nloc) {
            __builtin_amdgcn_fence(__ATOMIC_RELEASE, "agent");
            asm volatile("s_waitcnt vmcnt(0)" ::: "memory");
            const unsigned og = xb_add(&bar[XB_TOP], 1u);
            const unsigned tg = og / nx;
            if (og + 1u == (tg + 1u) * nx) xb_add(&bar[XB_TOPGEN], 1u);
            else XB_SPIN(xb_ld(&bar[XB_TOPGEN]) == tg, bar);
            __builtin_amdgcn_fence(__ATOMIC_ACQUIRE, "agent");
            xb_add(&bar[XB_XGEN(b.x)], 1u);
            asm volatile("s_waitcnt vmcnt(0)" ::: "memory");
        } else {
            XB_SPIN(xb_ld(&bar[XB_XGEN(b.x)]) == gen, bar);
            __builtin_amdgcn_fence(__ATOMIC_ACQUIRE, "agent");
            asm volatile("s_waitcnt vmcnt(0)" ::: "memory");
        }
    }
    __syncthreads();
}

static_assert(XCD_BAR_WORDS * 4 <= BAR_BYTES, "barrier words");
struct Params { const float* in[16]; float* out; unsigned char* ws; int ph_lo, ph_hi; };

__device__ __forceinline__ float wave_sum(float v) {
#pragma unroll
    for (int o = 1; o < 64; o <<= 1) v += __shfl_xor(v, o);
    return v;
}
__device__ __forceinline__ float silu_f(float x) { return x * __builtin_amdgcn_rcpf(1.0f + __expf(-x)); }
__device__ __forceinline__ float bf2f(unsigned short b) { return __builtin_bit_cast(float, (unsigned)b << 16); }
__device__ __forceinline__ float bflo(unsigned w) { return __builtin_bit_cast(float, w << 16); }
__device__ __forceinline__ float bfhi(unsigned w) { return __builtin_bit_cast(float, w & 0xffff0000u); }
__device__ __forceinline__ u32x4 pack8(const f32x4 a, const f32x4 b) { u32x4 w; w.x = cvt_pk_bf16(a[0], a[1]); w.y = cvt_pk_bf16(a[2], a[3]); w.z = cvt_pk_bf16(b[0], b[1]); w.w = cvt_pk_bf16(b[2], b[3]); return w; }
__device__ __forceinline__ float row_rs(const float* part, int row) {
    const f32x4* p = (const f32x4*)(part + (size_t)row * 16);
    const f32x4 a = p[0], b = p[1], c = p[2], d = p[3];
    const float s = (((a[0] + a[1]) + (a[2] + a[3])) + ((b[0] + b[1]) + (b[2] + b[3]))) + (((c[0] + c[1]) + (c[2] + c[3])) + ((d[0] + d[1]) + (d[2] + d[3])));
    return rsqrtf(s * (1.0f / D) + RMS_EPS);
}

typedef f32x4 Acc[2][2][4][2];

struct EpiConvIn {
    static constexpr bool PERM = true, AFTER_DRAIN = false;
    const float* part; bf16_t* bb; bf16_t* ub; float* convp; float* convs;
    __device__ __forceinline__ void operator()(const Acc& acc, const pg8::Unit& u, int wr, int wc, int fr, int fq) const {
#pragma unroll
        for (int ai = 0; ai < 2; ++ai)
#pragma unroll
            for (int m = 0; m < 4; ++m) {
                const int row = u.pm * 256 + ai * 128 + wr * 64 + m * 16 + fr;
                const float rs = row_rs(part, row);
                if (u.pn < 4) {
#pragma unroll
                    for (int bj = 0; bj < 2; ++bj) { const int col = u.pn * 256 + bj * 128 + wc * 32 + 8 * fq;
                        *(u32x4*)(bb + (size_t)row * D + col) = pack8(acc[ai][bj][m][0] * rs, acc[ai][bj][m][1] * rs); }
                } else {
                    const int col = (u.pn - 4) * 128 + wc * 32 + 8 * fq;
                    const f32x4 u0 = (acc[ai][0][m][0] * rs) * (acc[ai][1][m][0] * rs), u1 = (acc[ai][0][m][1] * rs) * (acc[ai][1][m][1] * rs);
                    *(u32x4*)(ub + (size_t)row * D + col) = pack8(u0, u1);
                    float* dst = nullptr;
                    if (row < TP) { const int l = row & (SEQ - 1); if (l >= SEQ - 2) dst = convp + ((size_t)(row >> 11) * 2 + (l - (SEQ - 2))) * D + col; }
                    else { const int ts = row - TP, l = ts & 3; if (l >= 2) dst = convs + ((size_t)(ts >> 2) * 2 + (l - 2)) * D + col; }
                    if (dst) { *(f32x4*)dst = u0; *(f32x4*)(dst + 4) = u1; }
                }
            }
    }
};

template <int MODE> struct EpiResid {
    static constexpr bool PERM = true, AFTER_DRAIN = false;
    const float* xp; const float* xs; float* xres; bf16_t* xb; float* part; float* split;
    __device__ __forceinline__ void operator()(const Acc& acc, const pg8::Unit& u, int wr, int wc, int fr, int fq) const {
        if (u.pm >= TP / 256) {
#pragma unroll
            for (int ai = 0; ai < 2; ++ai)
#pragma unroll
                for (int m = 0; m < 4; ++m) {
                    const int row = u.pm * 256 + ai * 128 + wr * 64 + m * 16 + fr;
#pragma unroll
                    for (int bj = 0; bj < 2; ++bj) { float* dst = split + ((size_t)(u.kt0 >> 2) * TS + (row - TP)) * D + u.pn * 256 + bj * 128 + wc * 32 + 8 * fq;
                        *(f32x4*)dst = acc[ai][bj][m][0]; *(f32x4*)(dst + 4) = acc[ai][bj][m][1]; }
                }
            return;
        }
#pragma unroll
        for (int ai = 0; ai < 2; ++ai)
#pragma unroll
            for (int m = 0; m < 4; ++m) {
                const int row = u.pm * 256 + ai * 128 + wr * 64 + m * 16 + fr;
                const float* src = row < TP ? xp + (size_t)row * D : xs + (size_t)(row - TP) * D;
                float ss = 0.f;
#pragma unroll
                for (int bj = 0; bj < 2; ++bj) { const int col = u.pn * 256 + bj * 128 + wc * 32 + 8 * fq;
                    f32x4 r0, r1;
                    if (MODE == 0) { r0 = *(const f32x4*)(src + col); r1 = *(const f32x4*)(src + col + 4); }
                    else { const u32x4 w = *(const u32x4*)(xb + (size_t)row * D + col); r0 = (f32x4){bflo(w.x), bfhi(w.x), bflo(w.y), bfhi(w.y)}; r1 = (f32x4){bflo(w.z), bfhi(w.z), bflo(w.w), bfhi(w.w)}; }
                    const f32x4 v0 = acc[ai][bj][m][0] + r0, v1 = acc[ai][bj][m][1] + r1;
                    *(u32x4*)(xb + (size_t)row * D + col) = pack8(v0, v1);
                    if (MODE != 2) {
                        ss += ((v0[0] * v0[0] + v0[1] * v0[1]) + (v0[2] * v0[2] + v0[3] * v0[3])) + ((v1[0] * v1[0] + v1[1] * v1[1]) + (v1[2] * v1[2] + v1[3] * v1[3])); } }
                if (MODE != 2) { ss += __shfl_xor(ss, 16); ss += __shfl_xor(ss, 32);
                    if (fq == 0) part[(size_t)row * 16 + u.pn * 4 + wc] = ss; }
            }
    }
};

struct EpiSwiGLU {
    static constexpr bool PERM = true, AFTER_DRAIN = false;
    const float* part; bf16_t* hff;
    __device__ __forceinline__ void operator()(const Acc& acc, const pg8::Unit& u, int wr, int wc, int fr, int fq) const {
#pragma unroll
        for (int ai = 0; ai < 2; ++ai)
#pragma unroll
            for (int m = 0; m < 4; ++m) {
                const int row = u.pm * 256 + ai * 128 + wr * 64 + m * 16 + fr;
                const float rs = row_rs(part, row);
                const int col = u.pn * 128 + wc * 32 + 8 * fq;
                f32x4 h[2];
#pragma unroll
                for (int n = 0; n < 2; ++n)
#pragma unroll
                    for (int e = 0; e < 4; ++e) h[n][e] = silu_f(acc[ai][0][m][n][e] * rs) * (acc[ai][1][m][n][e] * rs);
                *(u32x4*)(hff + (size_t)row * DFF + col) = pack8(h[0], h[1]);
            }
    }
};

struct EpiRetIn {
    static constexpr bool PERM = true, AFTER_DRAIN = false;
    const float* part; const float* rope; bf16_t* Q; bf16_t* K; bf16_t* V; bf16_t* G;
    __device__ __forceinline__ void operator()(const Acc& acc, const pg8::Unit& u, int wr, int wc, int fr, int fq) const {
#pragma unroll
        for (int ai = 0; ai < 2; ++ai)
#pragma unroll
            for (int m = 0; m < 4; ++m) {
                const int row = u.pm * 256 + ai * 128 + wr * 64 + m * 16 + fr;
                const float rs = row_rs(part, row);
                if (u.pn < 8) {
                    const int pidx = row < TP ? (row & (SEQ - 1)) : SEQ + ((row - TP) & 3);
                    const int i0 = wc * 32 + 8 * fq;
                    const f32x4* cs = (const f32x4*)(rope + ((size_t)pidx * 128 + i0) * 2);
                    const float sc = (u.pn < 4) ? rs : rs * 0.0625f;
                    f32x4 o1[2], o2[2];
#pragma unroll
                    for (int n = 0; n < 2; ++n) { const f32x4 c01 = cs[2 * n], c23 = cs[2 * n + 1];
                        const f32x4 x1 = acc[ai][0][m][n] * sc, x2 = acc[ai][1][m][n] * sc;
                        const f32x4 cc = (f32x4){c01[0], c01[2], c23[0], c23[2]}, sn = (f32x4){c01[1], c01[3], c23[1], c23[3]};
                        o1[n] = x1 * cc - x2 * sn; o2[n] = x1 * sn + x2 * cc; }
                    bf16_t* dst = (u.pn < 4 ? Q : K) + (size_t)row * D + (u.pn & 3) * 256 + i0;
                    *(u32x4*)dst = pack8(o1[0], o1[1]); *(u32x4*)(dst + 128) = pack8(o2[0], o2[1]);
                } else if (u.pn < 16) {
#pragma unroll
                    for (int bj = 0; bj < 2; ++bj) { const int col = (u.pn - 8) * 256 + bj * 128 + wc * 32 + 8 * fq;
                        *(u32x4*)(V + (size_t)row * VD + col) = pack8(acc[ai][bj][m][0] * rs, acc[ai][bj][m][1] * rs); }
                } else {
#pragma unroll
                    for (int bj = 0; bj < 2; ++bj) { const int col = (u.pn - 16) * 256 + bj * 128 + wc * 32 + 8 * fq;
                        f32x4 g[2];
#pragma unroll
                        for (int n = 0; n < 2; ++n)
#pragma unroll
                            for (int e = 0; e < 4; ++e) g[n][e] = silu_f(acc[ai][bj][m][n][e] * rs);
                        *(u32x4*)(G + (size_t)row * VD + col) = pack8(g[0], g[1]); }
                }
            }
    }
};

__device__ __forceinline__ void transpose_item(const float* W, int K, int N, const float* gain, bf16_t* WT, int kind, LAS float* scr, int item, int lane) {
    const int nblk = N / 32, kb = item / nblk, nb = item % nblk, k0 = 64 * kb, n0 = 32 * nb;
    int drow;
    if (kind == 0) drow = n0;
    else if (kind == 1) { if (n0 < 1024) drow = n0; else { const int hh = (n0 - 1024) >> 10, j = (n0 - 1024) & 1023; drow = 1024 + (j >> 7) * 256 + hh * 128 + (j & 127); } }
    else if (kind == 2) drow = (n0 >> 7) * 256 + (n0 & 127);
    else drow = (n0 >> 7) * 256 + 128 + (n0 & 127);
    { const int kq = lane >> 3, n4 = (lane & 7) * 4;
        f32x4 v[8];
#pragma unroll
        for (int i = 0; i < 8; ++i) v[i] = *(const f32x4*)(W + (size_t)(k0 + kq + 8 * i) * N + n0 + n4);
        if (gain) {
#pragma unroll
            for (int i = 0; i < 8; ++i) v[i] = v[i] * gain[k0 + kq + 8 * i]; }
#pragma unroll
        for (int i = 0; i < 8; ++i) { LAS float* d = scr + (kq + 8 * i) * 33 + n4; d[0] = v[i][0]; d[1] = v[i][1]; d[2] = v[i][2]; d[3] = v[i][3]; } }
    asm volatile("s_waitcnt lgkmcnt(0)" ::: "memory");
    const int c = lane & 7;
#pragma unroll
    for (int j = 0; j < 4; ++j) { const int n = (lane >> 3) + 8 * j; const LAS float* s = scr + (8 * c) * 33 + n;
        u32x4 o; o.x = cvt_pk_bf16(s[0 * 33], s[1 * 33]); o.y = cvt_pk_bf16(s[2 * 33], s[3 * 33]); o.z = cvt_pk_bf16(s[4 * 33], s[5 * 33]); o.w = cvt_pk_bf16(s[6 * 33], s[7 * 33]);
        *(u32x4*)(WT + (size_t)(drow + n) * K + k0 + 8 * c) = o; }
    asm volatile("s_waitcnt lgkmcnt(0)" ::: "memory");
}

__device__ __forceinline__ void transpose_group(const Params& p, LAS unsigned char* lds, int grp, int gw, int NGW) {
    const int lane = threadIdx.x & 63, wave = __builtin_amdgcn_readfirstlane(threadIdx.x >> 6);
    LAS float* scr = (LAS float*)(lds + wave * 16384);
    unsigned char* ws = p.ws;
    constexpr int I_CIN = 16 * 96, I_COUT = 16 * 32, I_G = 16 * 88, I_D = 44 * 32, I_RIN = 16 * 192, I_ROUT = 32 * 32;
    if (grp == 0) {
        for (int r = gw; r < I_CIN; r += NGW) transpose_item(p.in[6], 1024, 3072, p.in[4], (bf16_t*)(ws + WS_WCIN), 1, scr, r, lane);
    } else if (grp == 1) {
        for (int it = gw; it < I_COUT + 2 * I_G + I_D; it += NGW) { int r = it;
            if (r < I_COUT) { transpose_item(p.in[8], 1024, 1024, nullptr, (bf16_t*)(ws + WS_WCOUT), 0, scr, r, lane); continue; } r -= I_COUT;
            if (r < I_G) { transpose_item(p.in[12], 1024, DFF, p.in[5], (bf16_t*)(ws + WS_WGU0), 2, scr, r, lane); continue; } r -= I_G;
            if (r < I_G) { transpose_item(p.in[13], 1024, DFF, p.in[5], (bf16_t*)(ws + WS_WGU0), 3, scr, r, lane); continue; } r -= I_G;
            transpose_item(p.in[14], DFF, 1024, nullptr, (bf16_t*)(ws + WS_WD0), 0, scr, r, lane); }
    } else if (grp == 2) {
        for (int r = gw; r < I_RIN; r += NGW) transpose_item(p.in[9], 1024, RIN, p.in[4] + D, (bf16_t*)(ws + WS_WRIN), 0, scr, r, lane);
    } else {
        for (int it = gw; it < I_ROUT + 2 * I_G + I_D; it += NGW) { int r = it;
            if (r < I_ROUT) { transpose_item(p.in[11], VD, 1024, p.in[10], (bf16_t*)(ws + WS_WROUT), 0, scr, r, lane); continue; } r -= I_ROUT;
            if (r < I_G) { transpose_item(p.in[12] + (size_t)1024 * DFF, 1024, DFF, p.in[5] + D, (bf16_t*)(ws + WS_WGU1), 2, scr, r, lane); continue; } r -= I_G;
            if (r < I_G) { transpose_item(p.in[13] + (size_t)1024 * DFF, 1024, DFF, p.in[5] + D, (bf16_t*)(ws + WS_WGU1), 3, scr, r, lane); continue; } r -= I_G;
            transpose_item(p.in[14] + (size_t)DFF * 1024, DFF, 1024, nullptr, (bf16_t*)(ws + WS_WD1), 0, scr, r, lane); }
    }
}
__device__ __forceinline__ void idle_slot_transposes(const Params& p, LAS unsigned char* lds, int grp, int nwg, int G, int bx) {
    if (G != 256) return;
    const int R = (nwg + G - 1) / G, busy = nwg - (R - 1) * G;
    if (bx < busy) return;
    const int wave = __builtin_amdgcn_readfirstlane(threadIdx.x >> 6);
    transpose_group(p, lds, grp, (bx - busy) * NWAVES + wave, (G - busy) * NWAVES);
}
__device__ __forceinline__ void phase_prologue(const Params& p, LAS unsigned char* lds, int vcu, int G) {
    const int tid = threadIdx.x, lane = tid & 63, wave = __builtin_amdgcn_readfirstlane(tid >> 6);
    LAS float* scr = (LAS float*)(lds + wave * 16384);
    const int gw = vcu * NWAVES + wave, NGW = G * NWAVES;
    unsigned char* ws = p.ws;
    if (G == 256) transpose_group(p, lds, 0, gw, NGW);
    else { for (int grp = 0; grp < 4; ++grp) transpose_group(p, lds, grp, gw, NGW); }
    bf16_t* xb = (bf16_t*)(ws + WS_XB); float* part = (float*)(ws + WS_PART);
    for (int rowb = gw * 2; rowb < T; rowb += NGW * 2) {
      f32x4 xv[2][4];
#pragma unroll
      for (int k = 0; k < 2; ++k) { const int row = rowb + k; const float* xr = row < TP ? p.in[0] + (size_t)row * D : p.in[1] + (size_t)(row - TP) * D;
#pragma unroll
        for (int j = 0; j < 2; ++j) { xv[k][2 * j] = __builtin_nontemporal_load((const f32x4*)(xr + j * 512 + lane * 8)); xv[k][2 * j + 1] = __builtin_nontemporal_load((const f32x4*)(xr + j * 512 + lane * 8 + 4)); } }
#pragma unroll
      for (int k = 0; k < 2; ++k) { const int row = rowb + k; const float* xr = row < TP ? p.in[0] + (size_t)row * D : p.in[1] + (size_t)(row - TP) * D;
        float ss = 0.f;
#pragma unroll
        for (int j = 0; j < 2; ++j) { const int col = j * 512 + lane * 8;
            const f32x4 v0 = xv[k][2 * j], v1 = xv[k][2 * j + 1];
            *(u32x4*)(xb + (size_t)row * D + col) = pack8(v0, v1);
            ss += ((v0[0] * v0[0] + v0[1] * v0[1]) + (v0[2] * v0[2] + v0[3] * v0[3])) + ((v1[0] * v1[0] + v1[1] * v1[1]) + (v1[2] * v1[2] + v1[3] * v1[3])); }
        ss = wave_sum(ss);
        if (lane < 16) part[(size_t)row * 16 + lane] = (lane == 0) ? ss : 0.f;
    } }
    float* rope = (float*)(ws + WS_ROPE);
    for (int e = vcu * NTHREADS + tid; e < NROPE * 128; e += G * NTHREADS) {
        const int pi = e >> 7, i = e & 127;
        const double pos = pi < SEQ ? (double)pi : (double)(16384 + (pi - SEQ));
        const double inv = exp2(-(double)i * (13.287712379549449 / 128.0));
        const double ang = pos * inv;
        const double n = rint(ang * 0.15915494309189535);
        const float r = (float)(ang - n * 6.283185307179586);
        rope[2 * e] = __cosf(r); rope[2 * e + 1] = __sinf(r);
    }
}

__device__ __forceinline__ void unpack8(const u32x4 w, float* f) { f[0] = bflo(w.x); f[1] = bfhi(w.x); f[2] = bflo(w.y); f[3] = bfhi(w.y); f[4] = bflo(w.z); f[5] = bfhi(w.z); f[6] = bflo(w.w); f[7] = bfhi(w.w); }
__device__ __forceinline__ void phase_conv_sample(const Params& p, int vcu, int G) {
    unsigned char* ws = p.ws;
    const bf16_t* bb = (const bf16_t*)(ws + WS_BB); const bf16_t* ub = (const bf16_t*)(ws + WS_UB); bf16_t* a2 = (bf16_t*)(ws + WS_A2);
    const float* cw = p.in[7]; const float* sc = p.in[2];
    for (int it = TP * 128 + vcu * NTHREADS + threadIdx.x; it < T * 128; it += G * NTHREADS) {
        const int row = it >> 7, col = (it & 127) * 8;
        float b[8], u0[8], u1[8], u2[8];
        unpack8(*(const u32x4*)(bb + (size_t)row * D + col), b);
        unpack8(*(const u32x4*)(ub + (size_t)row * D + col), u2);
        int l; const float* buf = nullptr;
        if (row < TP) l = row & (SEQ - 1); else { const int ts = row - TP; l = ts & 3; buf = sc + (size_t)(ts >> 2) * 2 * D + col; }
        if (l >= 1) unpack8(*(const u32x4*)(ub + (size_t)(row - 1) * D + col), u1);
        else if (buf) { const f32x4 a = *(const f32x4*)(buf + D), c = *(const f32x4*)(buf + D + 4); u1[0] = a[0]; u1[1] = a[1]; u1[2] = a[2]; u1[3] = a[3]; u1[4] = c[0]; u1[5] = c[1]; u1[6] = c[2]; u1[7] = c[3]; }
        else {
#pragma unroll
            for (int e = 0; e < 8; ++e) u1[e] = 0.f; }
        if (l >= 2) unpack8(*(const u32x4*)(ub + (size_t)(row - 2) * D + col), u0);
        else if (buf) { const float* q = buf + (size_t)l * D; const f32x4 a = *(const f32x4*)q, c = *(const f32x4*)(q + 4); u0[0] = a[0]; u0[1] = a[1]; u0[2] = a[2]; u0[3] = a[3]; u0[4] = c[0]; u0[5] = c[1]; u0[6] = c[2]; u0[7] = c[3]; }
        else {
#pragma unroll
            for (int e = 0; e < 8; ++e) u0[e] = 0.f; }
        f32x4 o[2];
#pragma unroll
        for (int e = 0; e < 8; ++e) { const float y = cw[col + e] * u0[e] + cw[D + col + e] * u1[e] + cw[2 * D + col + e] * u2[e]; o[e >> 2][e & 3] = b[e] * y; }
        *(u32x4*)(a2 + (size_t)row * D + col) = pack8(o[0], o[1]);
    }
}

__device__ __forceinline__ void phase_conv(const Params& p, int vcu, int G) {
    unsigned char* ws = p.ws;
    const bf16_t* bb = (const bf16_t*)(ws + WS_BB); const bf16_t* ub = (const bf16_t*)(ws + WS_UB); bf16_t* a2 = (bf16_t*)(ws + WS_A2);
    const float* cw = p.in[7];
    const int col = (threadIdx.x & 127) * 8;
    float w0[8], w1[8], w2[8];
#pragma unroll
    for (int e = 0; e < 8; ++e) { w0[e] = cw[col + e]; w1[e] = cw[D + col + e]; w2[e] = cw[2 * D + col + e]; }
    const int rstride = G * 4;
    for (int r0 = vcu * 4 + (threadIdx.x >> 7); r0 < TP; r0 += 4 * rstride) {
        u32x4 vb[4], v2[4], v1[4], v0[4];
#pragma unroll
        for (int k = 0; k < 4; ++k) { const int row = r0 + k * rstride; if (row < TP) { const int l = row & (SEQ - 1);
            vb[k] = __builtin_nontemporal_load((const u32x4*)(bb + (size_t)row * D + col)); v2[k] = *(const u32x4*)(ub + (size_t)row * D + col);
            v1[k] = *(const u32x4*)(ub + (size_t)(row - (l >= 1 ? 1 : 0)) * D + col); v0[k] = *(const u32x4*)(ub + (size_t)(row - (l >= 2 ? 2 : 0)) * D + col); } }
#pragma unroll
        for (int k = 0; k < 4; ++k) { const int row = r0 + k * rstride; if (row < TP) { const int l = row & (SEQ - 1);
            float b[8], u0[8], u1[8], u2[8]; unpack8(vb[k], b); unpack8(v2[k], u2); unpack8(v1[k], u1); unpack8(v0[k], u0);
            const float m1 = l >= 1 ? 1.f : 0.f, m0 = l >= 2 ? 1.f : 0.f;
            f32x4 o[2];
#pragma unroll
            for (int e = 0; e < 8; ++e) { const float y = w0[e] * (u0[e] * m0) + w1[e] * (u1[e] * m1) + w2[e] * u2[e]; o[e >> 2][e & 3] = b[e] * y; }
            __builtin_nontemporal_store(pack8(o[0], o[1]), (u32x4*)(a2 + (size_t)row * D + col)); } }
    }
    phase_conv_sample(p, vcu, G);
}

__device__ __forceinline__ bf16x8 tr_read2(LAS const unsigned char* a0, LAS const unsigned char* a1) {
    const s16x4 a = __builtin_amdgcn_ds_read_tr16_b64_v4i16((LAS s16x4*)a0);
    const s16x4 b = __builtin_amdgcn_ds_read_tr16_b64_v4i16((LAS s16x4*)a1);
    return (bf16x8){a[0], a[1], a[2], a[3], b[0], b[1], b[2], b[3]};
}
constexpr int KS_STRIDE = 528, VS_STRIDE = 144, ST_STRIDE = 528;
constexpr int LDS_KS = 0, LDS_VS = LDS_KS + 128 * KS_STRIDE, LDS_VW = LDS_VS + 128 * VS_STRIDE, LDS_ST = LDS_VW + 128 * VS_STRIDE, LDS_RET_END = LDS_ST + 64 * ST_STRIDE;
static_assert(LDS_RET_END <= LDS_BYTES, "retention LDS");

__device__ __forceinline__ void retention_prompt_unit(const Params& p, LAS unsigned char* lds, int unit) {
    const int tid = threadIdx.x, lane = tid & 63, wid = __builtin_amdgcn_readfirstlane(tid >> 6), fr = lane & 15, fq = lane >> 4;
    const int b = unit >> 5, h = (unit >> 3) & 3, vb = unit & 7;
    unsigned char* ws = p.ws;
    const bf16_t* Qg = (const bf16_t*)(ws + WS_Q) + (size_t)b * SEQ * D + h * 256;
    const bf16_t* Kg = (const bf16_t*)(ws + WS_K) + (size_t)b * SEQ * D + h * 256;
    const bf16_t* Vg = (const bf16_t*)(ws + WS_V) + (size_t)b * SEQ * VD + h * 512 + vb * 64;
    bf16_t* Og = (bf16_t*)(ws + WS_O) + (size_t)b * SEQ * VD + h * 512 + vb * 64;
    const float log2g = __log2f(1.0f - exp2f(-5.0f - (float)h));
    const float gC = exp2f(128.0f * log2g);
    f32x4 S[2][4];
#pragma unroll
    for (int mt = 0; mt < 2; ++mt)
#pragma unroll
        for (int nt = 0; nt < 4; ++nt) S[mt][nt] = (f32x4){0.f, 0.f, 0.f, 0.f};
    LAS unsigned char* Ks = lds + LDS_KS; LAS unsigned char* Vs = lds + LDS_VS; LAS unsigned char* Vw = lds + LDS_VW; LAS unsigned char* St = lds + LDS_ST;
    for (int c = 0; c < 16; ++c) {
        __syncthreads();
#pragma unroll
        for (int mt = 0; mt < 2; ++mt)
#pragma unroll
            for (int nt = 0; nt < 4; ++nt) { u32x2 w; w.x = cvt_pk_bf16(S[mt][nt][0], S[mt][nt][1]); w.y = cvt_pk_bf16(S[mt][nt][2], S[mt][nt][3]);
                *(LAS u32x2*)(St + (nt * 16 + fr) * ST_STRIDE + (32 * wid + 16 * mt + fq * 4) * 2) = w; }
#pragma unroll
        for (int i = 0; i < 8; ++i) { const int id = tid + i * NTHREADS, row = id >> 5, cc = id & 31;
            *(LAS u32x4*)(Ks + row * KS_STRIDE + cc * 16) = *(const u32x4*)(Kg + (size_t)(c * 128 + row) * D + cc * 8); }
#pragma unroll
        for (int i = 0; i < 2; ++i) { const int id = tid + i * NTHREADS, row = id >> 3, cc = id & 7;
            const u32x4 v = *(const u32x4*)(Vg + (size_t)(c * 128 + row) * VD + cc * 8);
            *(LAS u32x4*)(Vs + row * VS_STRIDE + cc * 16) = v;
            const float sw = exp2f((float)(127 - row) * log2g);
            u32x4 w; w.x = cvt_pk_bf16(bflo(v.x) * sw, bfhi(v.x) * sw); w.y = cvt_pk_bf16(bflo(v.y) * sw, bfhi(v.y) * sw); w.z = cvt_pk_bf16(bflo(v.z) * sw, bfhi(v.z) * sw); w.w = cvt_pk_bf16(bflo(v.w) * sw, bfhi(v.w) * sw);
            *(LAS u32x4*)(Vw + row * VS_STRIDE + cc * 16) = w; }
        bf16x8 qf[8];
#pragma unroll
        for (int ks = 0; ks < 8; ++ks) qf[ks] = *(const bf16x8*)(Qg + (size_t)(c * 128 + 16 * wid + fr) * D + ks * 32 + fq * 8);
        __syncthreads();
        f32x4 sc[8];
#pragma unroll
        for (int jt = 0; jt < 8; ++jt) {
            sc[jt] = (f32x4){0.f, 0.f, 0.f, 0.f};
            if (jt <= wid) {
#pragma unroll
                for (int ks = 0; ks < 8; ++ks) { const bf16x8 kf = *(const LAS bf16x8*)(Ks + (jt * 16 + fr) * KS_STRIDE + ks * 64 + fq * 16);
                    sc[jt] = __builtin_amdgcn_mfma_f32_16x16x32_bf16(kf, qf[ks], sc[jt], 0, 0, 0); }
#pragma unroll
                for (int r = 0; r < 4; ++r) { const int dij = 16 * (wid - jt) + fr - fq * 4 - r;
                    sc[jt][r] = dij >= 0 ? sc[jt][r] * exp2f((float)dij * log2g) : 0.f; }
            }
        }
        f32x4 o[4];
#pragma unroll
        for (int nt = 0; nt < 4; ++nt) {
            o[nt] = (f32x4){0.f, 0.f, 0.f, 0.f};
#pragma unroll
            for (int ks = 0; ks < 8; ++ks) { const bf16x8 sf = *(const LAS bf16x8*)(St + (nt * 16 + fr) * ST_STRIDE + ks * 64 + fq * 16);
                o[nt] = __builtin_amdgcn_mfma_f32_16x16x32_bf16(qf[ks], sf, o[nt], 0, 0, 0); }
#pragma unroll
            for (int r = 0; r < 4; ++r) o[nt][r] *= exp2f((float)(16 * wid + fq * 4 + r + 1) * log2g);
        }
#pragma unroll
        for (int a = 0; a < 4; ++a) {
            if (2 * a <= wid) {
                bf16x8 pa; { const unsigned w0 = cvt_pk_bf16(sc[2 * a][0], sc[2 * a][1]), w1 = cvt_pk_bf16(sc[2 * a][2], sc[2 * a][3]), w2 = cvt_pk_bf16(sc[2 * a + 1][0], sc[2 * a + 1][1]), w3 = cvt_pk_bf16(sc[2 * a + 1][2], sc[2 * a + 1][3]);
                    const u32x4 w = (u32x4){w0, w1, w2, w3}; pa = __builtin_bit_cast(bf16x8, w); }
#pragma unroll
                for (int nt = 0; nt < 4; ++nt) {
                    LAS const unsigned char* a0 = Vs + (32 * a + fq * 4 + (fr >> 2)) * VS_STRIDE + (nt * 16 + 4 * (fr & 3)) * 2;
                    const bf16x8 vf = tr_read2(a0, a0 + 16 * VS_STRIDE);
                    o[nt] = __builtin_amdgcn_mfma_f32_16x16x32_bf16(pa, vf, o[nt], 0, 0, 0); }
            }
        }
#pragma unroll
        for (int nt = 0; nt < 4; ++nt)
#pragma unroll
            for (int r = 0; r < 4; ++r) Og[(size_t)(c * 128 + 16 * wid + fq * 4 + r) * VD + nt * 16 + fr] = (bf16_t)(cvt_pk_bf16(o[nt][r], 0.f) & 0xffffu);
#pragma unroll
        for (int mt = 0; mt < 2; ++mt)
#pragma unroll
            for (int nt = 0; nt < 4; ++nt) S[mt][nt] = S[mt][nt] * gC;
#pragma unroll
        for (int ks = 0; ks < 4; ++ks) {
            bf16x8 af[2];
#pragma unroll
            for (int mt = 0; mt < 2; ++mt) { LAS const unsigned char* a0 = Ks + (ks * 32 + fq * 8 + (fr >> 2)) * KS_STRIDE + (32 * wid + 16 * mt + 4 * (fr & 3)) * 2;
                af[mt] = tr_read2(a0, a0 + 4 * KS_STRIDE); }
#pragma unroll
            for (int nt = 0; nt < 4; ++nt) { LAS const unsigned char* b0 = Vw + (ks * 32 + fq * 8 + (fr >> 2)) * VS_STRIDE + (nt * 16 + 4 * (fr & 3)) * 2;
                const bf16x8 bfr = tr_read2(b0, b0 + 4 * VS_STRIDE);
#pragma unroll
                for (int mt = 0; mt < 2; ++mt) S[mt][nt] = __builtin_amdgcn_mfma_f32_16x16x32_bf16(af[mt], bfr, S[mt][nt], 0, 0, 0); }
        }
    }
    float* So = p.out + OUT_RETP + ((size_t)(b * 4 + h) * 256) * 512 + vb * 64;
#pragma unroll
    for (int mt = 0; mt < 2; ++mt)
#pragma unroll
        for (int nt = 0; nt < 4; ++nt)
#pragma unroll
            for (int r = 0; r < 4; ++r) So[(size_t)(32 * wid + 16 * mt + fq * 4 + r) * 512 + nt * 16 + fr] = S[mt][nt][r];
}

constexpr int LDS_SQ = 0, LDS_SK = 4096, LDS_SA = 8192, LDS_SRED = 8448;
__device__ __forceinline__ void retention_sample_unit(const Params& p, LAS unsigned char* lds, int unit) {
    const int tid = threadIdx.x, lane = tid & 63, wid = __builtin_amdgcn_readfirstlane(tid >> 6);
    const int s = unit >> 2, h = unit & 3, t0 = TP + s * 4;
    unsigned char* ws = p.ws;
    const bf16_t* Qg = (const bf16_t*)(ws + WS_Q) + (size_t)t0 * D + h * 256;
    const bf16_t* Kg = (const bf16_t*)(ws + WS_K) + (size_t)t0 * D + h * 256;
    const bf16_t* Vg = (const bf16_t*)(ws + WS_V) + (size_t)t0 * VD + h * 512;
    bf16_t* Og = (bf16_t*)(ws + WS_O) + (size_t)t0 * VD + h * 512;
    const float g = 1.0f - exp2f(-5.0f - (float)h), g2 = g * g, g3 = g2 * g, g4 = g2 * g2;
    LAS f32x4* qs = (LAS f32x4*)(lds + LDS_SQ); LAS f32x4* kws = (LAS f32x4*)(lds + LDS_SK); LAS float* asc = (LAS float*)(lds + LDS_SA); LAS float* red = (LAS float*)(lds + LDS_SRED);
    __syncthreads();
    if (tid < 256) { const int d = tid;
        qs[d] = (f32x4){bf2f(Qg[d]), bf2f(Qg[D + d]), bf2f(Qg[2 * D + d]), bf2f(Qg[3 * D + d])};
        kws[d] = (f32x4){g3 * bf2f(Kg[d]), g2 * bf2f(Kg[D + d]), g * bf2f(Kg[2 * D + d]), bf2f(Kg[3 * D + d])}; }
#pragma unroll
    for (int e = 0; e < 2; ++e) { const int id = 2 * wid + e, i = id >> 2, j = id & 3;
        const u32x2 qw = *(const u32x2*)(Qg + (size_t)i * D + lane * 4), kw = *(const u32x2*)(Kg + (size_t)j * D + lane * 4);
        float d = (bflo(qw.x) * bflo(kw.x) + bfhi(qw.x) * bfhi(kw.x)) + (bflo(qw.y) * bflo(kw.y) + bfhi(qw.y) * bfhi(kw.y));
        d = wave_sum(d); if (lane == 0) asc[id] = d; }
    __syncthreads();
    const int v4 = tid & 127, rg = tid >> 7;
    f32x4 vj[4];
#pragma unroll
    for (int j = 0; j < 4; ++j) { const u32x2 w = *(const u32x2*)(Vg + (size_t)j * VD + v4 * 4); vj[j] = (f32x4){bflo(w.x), bfhi(w.x), bflo(w.y), bfhi(w.y)}; }
    f32x4 oa[4];
#pragma unroll
    for (int i = 0; i < 4; ++i) oa[i] = (f32x4){0.f, 0.f, 0.f, 0.f};
    const float* S0 = p.in[3] + ((size_t)(s * 4 + h) * 256) * 512 + v4 * 4;
    float* S1 = p.out + OUT_RETS + ((size_t)(s * 4 + h) * 256) * 512 + v4 * 4;
#pragma unroll 8
    for (int it = 0; it < 64; ++it) { const int d = it * 4 + rg;
        const f32x4 s0 = __builtin_nontemporal_load((const f32x4*)(S0 + (size_t)d * 512));
        const f32x4 q4 = qs[d], k4 = kws[d];
        oa[0] += q4[0] * s0; oa[1] += q4[1] * s0; oa[2] += q4[2] * s0; oa[3] += q4[3] * s0;
        const f32x4 sn = g4 * s0 + ((k4[0] * vj[0] + k4[1] * vj[1]) + (k4[2] * vj[2] + k4[3] * vj[3]));
        __builtin_nontemporal_store(sn, (f32x4*)(S1 + (size_t)d * 512)); }
#pragma unroll
    for (int i = 0; i < 4; ++i) *(LAS f32x4*)(red + ((rg * 4 + i) * 512 + v4 * 4)) = oa[i];
    __syncthreads();
    { const int i = rg;
        f32x4 cr = (f32x4){0.f, 0.f, 0.f, 0.f};
#pragma unroll
        for (int r = 0; r < 4; ++r) cr += *(LAS f32x4*)(red + ((r * 4 + i) * 512 + v4 * 4));
        const float cwi = i == 0 ? g : (i == 1 ? g2 : (i == 2 ? g3 : g4));
        f32x4 o = cr * cwi;
        float dec = 1.f;
        for (int j = i; j >= 0; --j) { o += (asc[i * 4 + j] * dec) * vj[j]; dec *= g; }
        u32x2 w; w.x = cvt_pk_bf16(o[0], o[1]); w.y = cvt_pk_bf16(o[2], o[3]);
        *(u32x2*)(Og + (size_t)i * VD + v4 * 4) = w; }
}


constexpr int LDS_FQ = LDS_RET_END, LDS_FK = LDS_FQ + 4096, LDS_FA = LDS_FK + 4096;
static_assert(LDS_FA + 64 <= LDS_XB_ST, "fused retention LDS");
__device__ __forceinline__ void retention_fused(const Params& p, LAS unsigned char* lds, int unit) {
    const int tid = threadIdx.x, lane = tid & 63, wid = __builtin_amdgcn_readfirstlane(tid >> 6), fr = lane & 15, fq = lane >> 4;
    const int b = unit >> 5, h = (unit >> 3) & 3, vb = unit & 7;
    unsigned char* ws = p.ws;
    const bf16_t* Qg = (const bf16_t*)(ws + WS_Q) + (size_t)b * SEQ * D + h * 256;
    const bf16_t* Kg = (const bf16_t*)(ws + WS_K) + (size_t)b * SEQ * D + h * 256;
    const bf16_t* Vg = (const bf16_t*)(ws + WS_V) + (size_t)b * SEQ * VD + h * 512 + vb * 64;
    bf16_t* Og = (bf16_t*)(ws + WS_O) + (size_t)b * SEQ * VD + h * 512 + vb * 64;
    const float log2g = __log2f(1.0f - exp2f(-5.0f - (float)h));
    const float gC = exp2f(128.0f * log2g);
    f32x4 S[2][4];
#pragma unroll
    for (int mt = 0; mt < 2; ++mt)
#pragma unroll
        for (int nt = 0; nt < 4; ++nt) S[mt][nt] = (f32x4){0.f, 0.f, 0.f, 0.f};
    LAS unsigned char* Ks = lds + LDS_KS; LAS unsigned char* Vs = lds + LDS_VS; LAS unsigned char* Vw = lds + LDS_VW; LAS unsigned char* St = lds + LDS_ST;
    LAS f32x4* qs = (LAS f32x4*)(lds + LDS_FQ); LAS f32x4* kws = (LAS f32x4*)(lds + LDS_FK); LAS float* asc = (LAS float*)(lds + LDS_FA); LAS float* red = (LAS float*)(lds + 0);
    const int v4 = tid & 127, rg = tid >> 7;
    u32x2 vjp[4]; f32x4 oa[4];
    const float* S0 = nullptr; float* S1 = nullptr; bf16_t* Ogs = nullptr;
    float sg = 0.f, sg2 = 0.f, sg3 = 0.f, sg4 = 0.f;
#pragma unroll
    for (int i = 0; i < 4; ++i) { vjp[i] = (u32x2){0u, 0u}; oa[i] = (f32x4){0.f, 0.f, 0.f, 0.f}; }
    for (int c = 0; c < 16; ++c) {
        __syncthreads();
        if ((c & 7) == 0) {
            const int su = unit + (c >> 3) * 256, ss = su >> 2, sh = su & 3, t0 = TP + ss * 4;
            const bf16_t* Qs = (const bf16_t*)(ws + WS_Q) + (size_t)t0 * D + sh * 256;
            const bf16_t* Kq = (const bf16_t*)(ws + WS_K) + (size_t)t0 * D + sh * 256;
            const bf16_t* Vq = (const bf16_t*)(ws + WS_V) + (size_t)t0 * VD + sh * 512;
            Ogs = (bf16_t*)(ws + WS_O) + (size_t)t0 * VD + sh * 512;
            sg = 1.0f - exp2f(-5.0f - (float)sh); sg2 = sg * sg; sg3 = sg2 * sg; sg4 = sg2 * sg2;
            if (tid < 256) { const int d = tid;
                qs[d] = (f32x4){bf2f(Qs[d]), bf2f(Qs[D + d]), bf2f(Qs[2 * D + d]), bf2f(Qs[3 * D + d])};
                kws[d] = (f32x4){sg3 * bf2f(Kq[d]), sg2 * bf2f(Kq[D + d]), sg * bf2f(Kq[2 * D + d]), bf2f(Kq[3 * D + d])}; }
#pragma unroll
            for (int e = 0; e < 2; ++e) { const int id = 2 * wid + e, i = id >> 2, j = id & 3;
                const u32x2 qw = *(const u32x2*)(Qs + (size_t)i * D + lane * 4), kw = *(const u32x2*)(Kq + (size_t)j * D + lane * 4);
                float dd = (bflo(qw.x) * bflo(kw.x) + bfhi(qw.x) * bfhi(kw.x)) + (bflo(qw.y) * bflo(kw.y) + bfhi(qw.y) * bfhi(kw.y));
                dd = wave_sum(dd); if (lane == 0) asc[id] = dd; }
#pragma unroll
            for (int j = 0; j < 4; ++j) { vjp[j] = *(const u32x2*)(Vq + (size_t)j * VD + v4 * 4); oa[j] = (f32x4){0.f, 0.f, 0.f, 0.f}; }
            S0 = p.in[3] + ((size_t)(ss * 4 + sh) * 256) * 512 + v4 * 4;
            S1 = p.out + OUT_RETS + ((size_t)(ss * 4 + sh) * 256) * 512 + v4 * 4;
        }
#pragma unroll
        for (int mt = 0; mt < 2; ++mt)
#pragma unroll
            for (int nt = 0; nt < 4; ++nt) { u32x2 w; w.x = cvt_pk_bf16(S[mt][nt][0], S[mt][nt][1]); w.y = cvt_pk_bf16(S[mt][nt][2], S[mt][nt][3]);
                *(LAS u32x2*)(St + (nt * 16 + fr) * ST_STRIDE + (32 * wid + 16 * mt + fq * 4) * 2) = w; }
#pragma unroll
        for (int i = 0; i < 8; ++i) { const int id = tid + i * NTHREADS, row = id >> 5, cc = id & 31; *(LAS u32x4*)(Ks + row * KS_STRIDE + cc * 16) = *(const u32x4*)(Kg + (size_t)(c * 128 + row) * D + cc * 8); }
#pragma unroll
        for (int i = 0; i < 2; ++i) { const int id = tid + i * NTHREADS, row = id >> 3, cc = id & 7;
            const u32x4 v = *(const u32x4*)(Vg + (size_t)(c * 128 + row) * VD + cc * 8);
            *(LAS u32x4*)(Vs + row * VS_STRIDE + cc * 16) = v;
            const float sw = exp2f((float)(127 - row) * log2g);
            u32x4 w; w.x = cvt_pk_bf16(bflo(v.x) * sw, bfhi(v.x) * sw); w.y = cvt_pk_bf16(bflo(v.y) * sw, bfhi(v.y) * sw); w.z = cvt_pk_bf16(bflo(v.z) * sw, bfhi(v.z) * sw); w.w = cvt_pk_bf16(bflo(v.w) * sw, bfhi(v.w) * sw);
            *(LAS u32x4*)(Vw + row * VS_STRIDE + cc * 16) = w; }
        bf16x8 qf[8];
#pragma unroll
        for (int ks = 0; ks < 8; ++ks) qf[ks] = *(const bf16x8*)(Qg + (size_t)(c * 128 + 16 * wid + fr) * D + ks * 32 + fq * 8);
        __syncthreads();
        f32x4 s0v[4];
        const int dbase = (c & 7) * 32 + rg;
#define SAMPLE_ISSUE(hb) do { _Pragma("unroll") for (int i = 0; i < 4; ++i) s0v[i] = __builtin_nontemporal_load((const f32x4*)(S0 + (size_t)(dbase + 4 * ((hb) * 4 + i)) * 512)); } while (0)
#define SAMPLE_CONSUME(hb) do { const f32x4 vj0 = (f32x4){bflo(vjp[0].x), bfhi(vjp[0].x), bflo(vjp[0].y), bfhi(vjp[0].y)}, vj1 = (f32x4){bflo(vjp[1].x), bfhi(vjp[1].x), bflo(vjp[1].y), bfhi(vjp[1].y)}, \
            vj2 = (f32x4){bflo(vjp[2].x), bfhi(vjp[2].x), bflo(vjp[2].y), bfhi(vjp[2].y)}, vj3 = (f32x4){bflo(vjp[3].x), bfhi(vjp[3].x), bflo(vjp[3].y), bfhi(vjp[3].y)}; \
        _Pragma("unroll") for (int i = 0; i < 4; ++i) { const int d = dbase + 4 * ((hb) * 4 + i); \
            const f32x4 q4 = qs[d], k4 = kws[d], s0 = s0v[i]; \
            oa[0] += q4[0] * s0; oa[1] += q4[1] * s0; oa[2] += q4[2] * s0; oa[3] += q4[3] * s0; \
            const f32x4 sn = sg4 * s0 + ((k4[0] * vj0 + k4[1] * vj1) + (k4[2] * vj2 + k4[3] * vj3)); \
            __builtin_nontemporal_store(sn, (f32x4*)(S1 + (size_t)d * 512)); } } while (0)
        SAMPLE_ISSUE(0);
        f32x4 o[4];
#pragma unroll
        for (int nt = 0; nt < 4; ++nt) {
            o[nt] = (f32x4){0.f, 0.f, 0.f, 0.f};
#pragma unroll
            for (int ks = 0; ks < 8; ++ks) { const bf16x8 sf = *(const LAS bf16x8*)(St + (nt * 16 + fr) * ST_STRIDE + ks * 64 + fq * 16);
                o[nt] = __builtin_amdgcn_mfma_f32_16x16x32_bf16(qf[ks], sf, o[nt], 0, 0, 0); }
#pragma unroll
            for (int r = 0; r < 4; ++r) o[nt][r] *= exp2f((float)(16 * wid + fq * 4 + r + 1) * log2g);
        }
#pragma unroll 1
        for (int a = 0; 2 * a <= wid; ++a) {
            {
                f32x4 sc[2];
#pragma unroll
                for (int t = 0; t < 2; ++t) { const int jt = 2 * a + t;
                    sc[t] = (f32x4){0.f, 0.f, 0.f, 0.f};
                    if (jt <= wid) {
#pragma unroll
                        for (int ks = 0; ks < 8; ++ks) { const bf16x8 kf = *(const LAS bf16x8*)(Ks + (jt * 16 + fr) * KS_STRIDE + ks * 64 + fq * 16);
                            sc[t] = __builtin_amdgcn_mfma_f32_16x16x32_bf16(kf, qf[ks], sc[t], 0, 0, 0); }
#pragma unroll
                        for (int r = 0; r < 4; ++r) { const int dij = 16 * (wid - jt) + fr - fq * 4 - r;
                            sc[t][r] = dij >= 0 ? sc[t][r] * exp2f((float)dij * log2g) : 0.f; }
                    } }
                bf16x8 pa; { const u32x4 w = (u32x4){cvt_pk_bf16(sc[0][0], sc[0][1]), cvt_pk_bf16(sc[0][2], sc[0][3]), cvt_pk_bf16(sc[1][0], sc[1][1]), cvt_pk_bf16(sc[1][2], sc[1][3])}; pa = __builtin_bit_cast(bf16x8, w); }
#pragma unroll
                for (int nt = 0; nt < 4; ++nt) {
                    LAS const unsigned char* a0 = Vs + (32 * a + fq * 4 + (fr >> 2)) * VS_STRIDE + (nt * 16 + 4 * (fr & 3)) * 2;
                    const bf16x8 vf = tr_read2(a0, a0 + 16 * VS_STRIDE);
                    o[nt] = __builtin_amdgcn_mfma_f32_16x16x32_bf16(pa, vf, o[nt], 0, 0, 0); }
            }
        }
        SAMPLE_CONSUME(0);
        SAMPLE_ISSUE(1);
#pragma unroll
        for (int nt = 0; nt < 4; ++nt)
#pragma unroll
            for (int r = 0; r < 4; ++r) Og[(size_t)(c * 128 + 16 * wid + fq * 4 + r) * VD + nt * 16 + fr] = (bf16_t)(cvt_pk_bf16(o[nt][r], 0.f) & 0xffffu);
#pragma unroll
        for (int mt = 0; mt < 2; ++mt)
#pragma unroll
            for (int nt = 0; nt < 4; ++nt) S[mt][nt] = S[mt][nt] * gC;
#pragma unroll
        for (int ks = 0; ks < 4; ++ks) {
            bf16x8 af[2];
#pragma unroll
            for (int mt = 0; mt < 2; ++mt) { LAS const unsigned char* a0 = Ks + (ks * 32 + fq * 8 + (fr >> 2)) * KS_STRIDE + (32 * wid + 16 * mt + 4 * (fr & 3)) * 2;
                af[mt] = tr_read2(a0, a0 + 4 * KS_STRIDE); }
#pragma unroll
            for (int nt = 0; nt < 4; ++nt) { LAS const unsigned char* b0 = Vw + (ks * 32 + fq * 8 + (fr >> 2)) * VS_STRIDE + (nt * 16 + 4 * (fr & 3)) * 2;
                const bf16x8 bfr = tr_read2(b0, b0 + 4 * VS_STRIDE);
#pragma unroll
                for (int mt = 0; mt < 2; ++mt) S[mt][nt] = __builtin_amdgcn_mfma_f32_16x16x32_bf16(af[mt], bfr, S[mt][nt], 0, 0, 0); }
        }
        SAMPLE_CONSUME(1);
        if ((c & 7) == 7) {
            __syncthreads();
#pragma unroll
            for (int i = 0; i < 4; ++i) *(LAS f32x4*)(red + ((rg * 4 + i) * 512 + v4 * 4)) = oa[i];
            __syncthreads();
            const int i = rg;
            f32x4 cr = (f32x4){0.f, 0.f, 0.f, 0.f};
#pragma unroll
            for (int r = 0; r < 4; ++r) cr += *(LAS f32x4*)(red + ((r * 4 + i) * 512 + v4 * 4));
            const float cwi = i == 0 ? sg : (i == 1 ? sg2 : (i == 2 ? sg3 : sg4));
            f32x4 oo = cr * cwi;
            const f32x4 vsel0 = (f32x4){bflo(vjp[0].x), bfhi(vjp[0].x), bflo(vjp[0].y), bfhi(vjp[0].y)}, vsel1 = (f32x4){bflo(vjp[1].x), bfhi(vjp[1].x), bflo(vjp[1].y), bfhi(vjp[1].y)}, vsel2 = (f32x4){bflo(vjp[2].x), bfhi(vjp[2].x), bflo(vjp[2].y), bfhi(vjp[2].y)}, vsel3 = (f32x4){bflo(vjp[3].x), bfhi(vjp[3].x), bflo(vjp[3].y), bfhi(vjp[3].y)};
            if (i >= 0) oo += (asc[i * 4 + 0] * (i == 0 ? 1.f : (i == 1 ? sg : (i == 2 ? sg2 : sg3)))) * vsel0;
            if (i >= 1) oo += (asc[i * 4 + 1] * (i == 1 ? 1.f : (i == 2 ? sg : sg2))) * vsel1;
            if (i >= 2) oo += (asc[i * 4 + 2] * (i == 2 ? 1.f : sg)) * vsel2;
            if (i >= 3) oo += asc[i * 4 + 3] * vsel3;
            u32x2 w; w.x = cvt_pk_bf16(oo[0], oo[1]); w.y = cvt_pk_bf16(oo[2], oo[3]);
            *(u32x2*)(Ogs + (size_t)i * VD + v4 * 4) = w;
        }
    }
#undef SAMPLE_ISSUE
#undef SAMPLE_CONSUME
    float* So = p.out + OUT_RETP + ((size_t)(b * 4 + h) * 256) * 512 + vb * 64;
#pragma unroll
    for (int mt = 0; mt < 2; ++mt)
#pragma unroll
        for (int nt = 0; nt < 4; ++nt)
#pragma unroll
            for (int r = 0; r < 4; ++r) So[(size_t)(32 * wid + 16 * mt + fq * 4 + r) * 512 + nt * 16 + fr] = S[mt][nt][r];
}

__device__ __forceinline__ void phase_retention(const Params& p, LAS unsigned char* lds, int vcu, int G) {
    if (G == 256) { retention_fused(p, lds, vcu); __syncthreads(); return; }
    for (int unit = vcu; unit < 256; unit += G) retention_prompt_unit(p, lds, unit);
    for (int unit = vcu; unit < 512; unit += G) retention_sample_unit(p, lds, unit);
    __syncthreads();
}

__device__ __forceinline__ void phase_gnorm(const Params& p, int vcu, int G) {
    const int tid = threadIdx.x, lane = tid & 63, wave = tid >> 6;
    unsigned char* ws = p.ws;
    const bf16_t* O = (const bf16_t*)(ws + WS_O); const bf16_t* Gt = (const bf16_t*)(ws + WS_G); bf16_t* A8 = (bf16_t*)(ws + WS_A8);
    for (int t0 = (vcu * NWAVES + wave) * 2; t0 < T; t0 += G * NWAVES * 2) {
        u32x4 xo[8], xg[8];
#pragma unroll
        for (int i = 0; i < 8; ++i) { const size_t off = (size_t)(t0 + (i >> 2)) * VD + (i & 3) * 512 + lane * 8; xo[i] = __builtin_nontemporal_load((const u32x4*)(O + off)); xg[i] = __builtin_nontemporal_load((const u32x4*)(Gt + off)); }
#pragma unroll
        for (int i = 0; i < 8; ++i) { const size_t off = (size_t)(t0 + (i >> 2)) * VD + (i & 3) * 512 + lane * 8;
            float x[8], g[8]; unpack8(xo[i], x); unpack8(xg[i], g);
            const float s1 = ((x[0] + x[1]) + (x[2] + x[3])) + ((x[4] + x[5]) + (x[6] + x[7]));
            const float mu = wave_sum(s1) * (1.0f / 512.0f);
            float q = 0.f;
#pragma unroll
            for (int e = 0; e < 8; ++e) { x[e] -= mu; q += x[e] * x[e]; }
            const float rstd = rsqrtf(wave_sum(q) * (1.0f / 512.0f) + GN_EPS);
            f32x4 o[2];
#pragma unroll
            for (int e = 0; e < 8; ++e) o[e >> 2][e & 3] = g[e] * (x[e] * rstd);
            __builtin_nontemporal_store(pack8(o[0], o[1]), (u32x4*)(A8 + off)); }
    }
}

template <int NSLICE, bool FIRST> __device__ __forceinline__ void sample_finalize(const Params& p, int vcu, int G) {
    const int tid = threadIdx.x, lane = tid & 63, wave = tid >> 6;
    unsigned char* ws = p.ws;
    bf16_t* xb = (bf16_t*)(ws + WS_XB); float* part = (float*)(ws + WS_PART); const float* split = (const float*)(ws + WS_SPLIT);
    for (int row = TP + vcu * NWAVES + wave; row < T; row += G * NWAVES) {
        float ss = 0.f;
#pragma unroll
        for (int j = 0; j < 2; ++j) { const int col = j * 512 + lane * 8;
            f32x4 v0, v1;
            if (FIRST) { const float* xs = p.in[1] + (size_t)(row - TP) * D + col; v0 = *(const f32x4*)xs; v1 = *(const f32x4*)(xs + 4); }
            else { const u32x4 w = *(const u32x4*)(xb + (size_t)row * D + col); v0 = (f32x4){bflo(w.x), bfhi(w.x), bflo(w.y), bfhi(w.y)}; v1 = (f32x4){bflo(w.z), bfhi(w.z), bflo(w.w), bfhi(w.w)}; }
#pragma unroll
            for (int sl = 0; sl < NSLICE; ++sl) { const float* sp = split + ((size_t)sl * TS + (row - TP)) * D + col; v0 += *(const f32x4*)sp; v1 += *(const f32x4*)(sp + 4); }
            *(u32x4*)(xb + (size_t)row * D + col) = pack8(v0, v1);
            ss += ((v0[0] * v0[0] + v0[1] * v0[1]) + (v0[2] * v0[2] + v0[3] * v0[3])) + ((v1[0] * v1[0] + v1[1] * v1[1]) + (v1[2] * v1[2] + v1[3] * v1[3])); }
        ss = wave_sum(ss);
        if (lane < 16) part[(size_t)row * 16 + lane] = (lane == 0) ? ss : 0.f;
    }
}
__device__ __forceinline__ void phase_final(const Params& p, int vcu, int G) {
    const int tid = threadIdx.x, lane = tid & 63, wave = tid >> 6;
    unsigned char* ws = p.ws;
    const float* gn = p.in[15]; const float* split = (const float*)(ws + WS_SPLIT); const bf16_t* xbq = (const bf16_t*)(ws + WS_XB);
    float* y = p.out + OUT_Y;
    f32x4 gg[4];
#pragma unroll
    for (int j = 0; j < 4; ++j) gg[j] = *(const f32x4*)(gn + j * 256 + lane * 4);
    for (int r0 = (vcu * NWAVES + wave) * 2; r0 < T; r0 += G * NWAVES * 2) {
        f32x4 v[2][4];
#pragma unroll
        for (int k = 0; k < 2; ++k)
#pragma unroll
            for (int j = 0; j < 4; ++j) { const u32x2 w = __builtin_nontemporal_load((const u32x2*)(xbq + (size_t)(r0 + k) * D + j * 256 + lane * 4)); v[k][j] = (f32x4){bflo(w.x), bfhi(w.x), bflo(w.y), bfhi(w.y)}; }
        if (r0 >= TP) {
#pragma unroll
            for (int k = 0; k < 2; ++k)
#pragma unroll
                for (int j = 0; j < 4; ++j)
#pragma unroll
                    for (int sl = 0; sl < 11; ++sl) v[k][j] += *(const f32x4*)(split + ((size_t)sl * TS + (r0 + k - TP)) * D + j * 256 + lane * 4);
        }
#pragma unroll
        for (int k = 0; k < 2; ++k) { float ss = 0.f;
#pragma unroll
            for (int j = 0; j < 4; ++j) ss += (v[k][j][0] * v[k][j][0] + v[k][j][1] * v[k][j][1]) + (v[k][j][2] * v[k][j][2] + v[k][j][3] * v[k][j][3]);
            const float rs = rsqrtf(wave_sum(ss) * (1.0f / D) + RMS_EPS);
#pragma unroll
            for (int j = 0; j < 4; ++j) __builtin_nontemporal_store(v[k][j] * rs * gg[j], (f32x4*)(y + (size_t)(r0 + k) * D + j * 256 + lane * 4)); }
    }
}

constexpr int NPHASES = 13;
__global__ void __launch_bounds__(NTHREADS, 2) mega_fwd(Params p) {
    extern __shared__ __attribute__((aligned(16))) unsigned char lds_raw[];
    LAS unsigned char* lds = (LAS unsigned char*)lds_raw;
    cg::grid_group grid = cg::this_grid();
    const int G = gridDim.x, bx = blockIdx.x;
    const int vcu = (G % 8 == 0) ? (bx % 8) * (G / 8) + bx / 8 : bx;
    unsigned char* ws = p.ws;
    const int lo = p.ph_lo, hi = p.ph_hi;
#define IN(k) (lo <= (k) && (k) < hi)
#define SEAM(k) do { if (IN(k) && IN((k) + 1)) { if (lo < 0) grid.sync(); else xcd_barrier(bar); } } while (0)
    if (threadIdx.x < 2) ((LAS unsigned*)(lds + LDS_XB_ST))[threadIdx.x] = 0u;
    __syncthreads();
    XcdBarrier bar; bar.bar = (unsigned*)(ws + WS_BAR); bar.x = 0; bar.st = nullptr;
    if (hi - lo > 1) bar = xcd_barrier_post((unsigned*)(ws + WS_BAR), (volatile LAS unsigned*)(lds + LDS_XB_ST));
    const float* part = (const float*)(ws + WS_PART);
    bf16_t* xb = (bf16_t*)(ws + WS_XB); float* xres = (float*)(ws + WS_XRES);

    if (IN(0)) { phase_prologue(p, lds, vcu, G); } SEAM(0);
    if (IN(1)) {
        pg8::Gemm g{xb, (const bf16_t*)(ws + WS_WCIN), T, 3072, 1024}; pg8::StaticOrder S; S.init(T, 3072, G, bx, g.K);
        EpiConvIn E{part, (bf16_t*)(ws + WS_BB), (bf16_t*)(ws + WS_UB), p.out + OUT_CONVP, p.out + OUT_CONVS};
        pg8::gemm_phase<EpiConvIn, pg8::StaticOrder, true, true>(lds, g, S, E);
        idle_slot_transposes(p, lds, 1, S.nwg, G, bx);
    } SEAM(1);
    if (IN(2)) { phase_conv(p, vcu, G); } SEAM(2);
    if (IN(3)) {
        pg8::Gemm g{(const bf16_t*)(ws + WS_A2), (const bf16_t*)(ws + WS_WCOUT), T, 1024, 1024}; pg8::SplitOrder S; S.init(TP, 1024, G, bx, g.K);
        EpiResid<1> E{p.in[0], p.in[1], xres, xb, (float*)(ws + WS_PART), (float*)(ws + WS_SPLIT)};
        pg8::gemm_phase<EpiResid<1>, pg8::SplitOrder, true, true>(lds, g, S, E);
    } SEAM(3);
    if (IN(4)) {
        sample_finalize<4, false>(p, vcu, G); xcd_barrier(bar);
        pg8::Gemm g{xb, (const bf16_t*)(ws + WS_WGU0), T, 5632, 1024}; pg8::StaticOrder S; S.init(T, 5632, G, bx, g.K);
        EpiSwiGLU E{part, (bf16_t*)(ws + WS_HFF)};
        pg8::gemm_phase<EpiSwiGLU, pg8::StaticOrder, true, true>(lds, g, S, E);
        idle_slot_transposes(p, lds, 2, S.nwg, G, bx);
    } SEAM(4);
    if (IN(5)) {
        pg8::Gemm g{(const bf16_t*)(ws + WS_HFF), (const bf16_t*)(ws + WS_WD0), T, 1024, DFF}; pg8::SplitOrder S; S.init(TP, 1024, G, bx, g.K);
        EpiResid<1> E{nullptr, nullptr, xres, xb, (float*)(ws + WS_PART), (float*)(ws + WS_SPLIT)};
        pg8::gemm_phase<EpiResid<1>, pg8::SplitOrder, true, true>(lds, g, S, E);
    } SEAM(5);
    if (IN(6)) {
        sample_finalize<11, false>(p, vcu, G); xcd_barrier(bar);
        pg8::Gemm g{xb, (const bf16_t*)(ws + WS_WRIN), T, RIN, 1024}; pg8::StaticOrder S; S.init(T, RIN, G, bx, g.K);
        EpiRetIn E{part, (const float*)(ws + WS_ROPE), (bf16_t*)(ws + WS_Q), (bf16_t*)(ws + WS_K), (bf16_t*)(ws + WS_V), (bf16_t*)(ws + WS_G)};
        pg8::gemm_phase<EpiRetIn, pg8::StaticOrder, true, true>(lds, g, S, E);
        idle_slot_transposes(p, lds, 3, S.nwg, G, bx);
    } SEAM(6);
    if (IN(7)) { phase_retention(p, lds, vcu, G); } SEAM(7);
    if (IN(8)) { phase_gnorm(p, vcu, G); } SEAM(8);
    if (IN(9)) {
        pg8::Gemm g{(const bf16_t*)(ws + WS_A8), (const bf16_t*)(ws + WS_WROUT), T, 1024, VD}; pg8::SplitOrder S; S.init(TP, 1024, G, bx, g.K);
        EpiResid<1> E{nullptr, nullptr, xres, xb, (float*)(ws + WS_PART), (float*)(ws + WS_SPLIT)};
        pg8::gemm_phase<EpiResid<1>, pg8::SplitOrder, true, true>(lds, g, S, E);
    } SEAM(9);
    if (IN(10)) {
        sample_finalize<8, false>(p, vcu, G); xcd_barrier(bar);
        pg8::Gemm g{xb, (const bf16_t*)(ws + WS_WGU1), T, 5632, 1024}; pg8::StaticOrder S; S.init(T, 5632, G, bx, g.K);
        EpiSwiGLU E{part, (bf16_t*)(ws + WS_HFF)};
        pg8::gemm_phase<EpiSwiGLU, pg8::StaticOrder, true, true>(lds, g, S, E);
    } SEAM(10);
    if (IN(11)) {
        pg8::Gemm g{(const bf16_t*)(ws + WS_HFF), (const bf16_t*)(ws + WS_WD1), T, 1024, DFF}; pg8::SplitOrder S; S.init(TP, 1024, G, bx, g.K);
        EpiResid<2> E{nullptr, nullptr, xres, xb, (float*)(ws + WS_PART), (float*)(ws + WS_SPLIT)};
        pg8::gemm_phase<EpiResid<2>, pg8::SplitOrder, true, true>(lds, g, S, E);
    } SEAM(11);
    if (IN(12)) { phase_final(p, vcu, G); }
#undef IN
#undef SEAM
}

extern "C" void kernel_launch(void* const* d_in, const int* in_sizes, int n_in, void* d_out, int out_size, void* d_ws, size_t ws_size, hipStream_t stream) {
    static int grid = 0;
    if (grid == 0) {
        if (n_in != 16 || (size_t)out_size != OUT_END || ws_size < WS_END) { fprintf(stderr, "kernel_launch: unexpected shapes: n_in %d out %d ws %zu (need %zu)\n", n_in, out_size, ws_size, (size_t)WS_END); grid = -1; return; }
        int dev = 0, cus = 0, per_cu = 0;
        (void)hipGetDevice(&dev); (void)hipDeviceGetAttribute(&cus, hipDeviceAttributeMultiprocessorCount, dev);
        if (hipFuncSetAttribute((const void*)mega_fwd, hipFuncAttributeMaxDynamicSharedMemorySize, LDS_BYTES) != hipSuccess) { fprintf(stderr, "kernel_launch: hipFuncSetAttribute failed\n"); grid = -1; return; }
        if (hipOccupancyMaxActiveBlocksPerMultiprocessor(&per_cu, (const void*)mega_fwd, NTHREADS, LDS_BYTES) != hipSuccess || per_cu < 1) { fprintf(stderr, "kernel_launch: occupancy query failed (%d)\n", per_cu); (void)hipGetLastError(); per_cu = 1; }
        grid = cus * per_cu;
        if (grid % 8 != 0 || grid <= 0) grid = cus;
    }
    if (grid < 0) return;
    if (hipMemsetAsync((unsigned char*)d_ws + WS_BAR, 0, BAR_BYTES, stream) != hipSuccess) { fprintf(stderr, "memset failed\n"); return; }
    Params p{};
    for (int i = 0; i < 16; ++i) p.in[i] = (const float*)d_in[i];
    p.out = (float*)d_out; p.ws = (unsigned char*)d_ws;
#if MK_N_LAUNCHES == 1
    p.ph_lo = 0; p.ph_hi = NPHASES;
    void* args[] = {&p};
    hipError_t e = hipLaunchCooperativeKernel((const void*)mega_fwd, dim3(grid), dim3(NTHREADS), args, LDS_BYTES, stream);
    if (e != hipSuccess) fprintf(stderr, "cooperative launch failed: %s (grid %d)\n", hipGetErrorString(e), grid);
#else
    for (int ph = 0; ph < NPHASES; ++ph) { p.ph_lo = ph; p.ph_hi = ph + 1; hipLaunchKernelGGL(mega_fwd, dim3(grid), dim3(NTHREADS), LDS_BYTES, stream, p); }
#endif
}
```

```cpp
#include <hip/hip_runtime.h>
#include <hip/hip_cooperative_groups.h>
#include <cstdio>
#include <cstdint>
namespace cg = cooperative_groups;

#ifndef MK_N_LAUNCHES
#define MK_N_LAUNCHES 1
#endif

namespace pg8 {
#define PG8_LAS __attribute__((address_space(3)))
typedef unsigned short bf16_t;
typedef short bf16x8 __attribute__((ext_vector_type(8)));
typedef float f32x4 __attribute__((ext_vector_type(4)));
typedef unsigned u32x4 __attribute__((ext_vector_type(4)));
constexpr int BM = 256, BK = 64, HALF = 128, HTB = HALF * BK * 2, STAGE_BYTES = 8 * HTB, NXCD = 8, WGM = 8;

__host__ __device__ __forceinline__ int lds_byte(int r, int c) { const int st = (r >> 4) * 2 + (c >> 5), rr = r & 15, cc = c & 31, ob = rr * 64 + cc * 2; return st * 1024 + (ob ^ (((ob >> 9) & 1) << 5)); }
__host__ __device__ __forceinline__ void stage_rc(int b, int& R, int& C) { const int st = b / 1024, sb = b % 1024, swz = sb ^ (((sb >> 9) & 1) << 5); R = (st >> 1) * 16 + swz / 64; C = (st & 1) * 32 + (swz % 64) / 2; }
__host__ __device__ __forceinline__ int perm32(int rho) { const int n = rho >> 4, i = rho & 15; return 8 * (i >> 2) + 4 * n + (i & 3); }

struct Unit { int pm, pn, kt0, nt; };
struct Gemm { const bf16_t* A; const bf16_t* Bt; int M, N, K; };

struct StaticOrder {
    int nM, nN, nwg, G, c, ntk;
    __host__ __device__ void init(int M, int N, int G_, int c_, int K) { nM = M / BM; nN = N / BM; nwg = nM * nN; G = G_; c = c_; ntk = K / BK; }
    __host__ __device__ bool next(int i, Unit& u) const {
        const long L = (long)i * G + c; if (L >= nwg) return false;
        int wgid = (int)L; { const int q = nwg / NXCD, r = nwg % NXCD, xcd = wgid % NXCD, off = wgid / NXCD; wgid = (xcd < r ? xcd * (q + 1) : r * (q + 1) + (xcd - r) * q) + off; }
        const int nig = WGM * nN, gid = wgid / nig, fm = gid * WGM, gsz = (nM - fm) < WGM ? (nM - fm) : WGM;
        u.pm = fm + ((wgid % nig) % gsz); u.pn = (wgid % nig) / gsz; u.kt0 = 0; u.nt = ntk; return true;
    }
    __device__ __forceinline__ void a_ready(const Unit&) const {}
    __device__ __forceinline__ void done(const Unit&) const {}
};
struct SplitOrder {
    StaticOrder P; int nslice, G, c;
    __host__ __device__ void init(int Mp, int N, int G_, int c_, int K) { P.init(Mp, N, G_, c_, K); nslice = (K / BK) / 4; G = G_; c = c_; }
    __host__ __device__ bool next(int i, Unit& u) const {
        const long L = (long)i * G + c;
        if (L < P.nwg) return P.next(i, u);
        const int j = (int)(L - P.nwg), nS = 2 * P.nN;
        if (j >= nS * nslice) return false;
        const int su = j % nS, sl = j / nS;
        u.pm = P.nM + su / P.nN; u.pn = su % P.nN; u.kt0 = sl * 4; u.nt = 4; return true;
    }
    __device__ __forceinline__ void a_ready(const Unit&) const {}
    __device__ __forceinline__ void done(const Unit&) const {}
};
typedef __bf16 bf16x2_cv __attribute__((ext_vector_type(2)));
typedef float f32x2_cv __attribute__((ext_vector_type(2)));
__device__ __forceinline__ unsigned cvt_pk_bf16(float lo, float hi) { const bf16x2_cv v = __builtin_convertvector((f32x2_cv){lo, hi}, bf16x2_cv); return __builtin_bit_cast(unsigned, v); }

template <class Epi, class Sched, bool ALIGN_EPI = false, bool SP2 = false>
__device__ __forceinline__ void gemm_phase(PG8_LAS unsigned char* lds, const Gemm g, const Sched& S, const Epi& E) {
    const int tid = threadIdx.x, wid = __builtin_amdgcn_readfirstlane(tid >> 6), lane = tid & 63, wr = wid >> 2, wc = wid & 3, fr = lane & 15, fq = lane >> 4;
    const int K = g.K;
    unsigned voffA[2], voffB[2];
#pragma unroll
    for (int i = 0; i < 2; ++i) { int R, C; stage_rc(tid * 16 + i * 8192, R, C); const int Rb = Epi::PERM ? ((R & ~31) + perm32(R & 31)) : R;
        voffA[i] = (unsigned)(R * K + C) * 2u; voffB[i] = (unsigned)(Rb * K + C) * 2u; }
    const size_t kstep = (size_t)(BK * 2);
    const size_t hstep = (size_t)HALF * K * 2;
    const size_t tstep = 2 * hstep;
    const unsigned ldsw = (unsigned)wid * 1024u;
    const int aoff = lds_byte(wr * 64 + fr, fq * 8), boff = lds_byte(wc * 32 + fr, fq * 8);
#define PG8_SA(b, h) (((b) * 2 + (h)) * HTB)
#define PG8_SB(b, h) ((4 + (b) * 2 + (h)) * HTB)
#define PG8_STAGE(bufoff, gbase, voff) do { _Pragma("unroll") for (int _i = 0; _i < 2; ++_i) \
        __builtin_amdgcn_global_load_lds((const unsigned*)((const char*)(gbase) + (voff)[_i]), (PG8_LAS unsigned*)(lds + (bufoff) + ldsw + _i * 8192), 16, 0, 0); } while (0)
#define PG8_LDA(dst, b, h) do { _Pragma("unroll") for (int m = 0; m < 4; ++m) _Pragma("unroll") for (int k = 0; k < 2; ++k) dst[m][k] = *(const PG8_LAS bf16x8*)(lds + PG8_SA(b, h) + aoff + m * 2048 + k * 1024); } while (0)
#define PG8_LDB(dst, b, h) do { _Pragma("unroll") for (int n = 0; n < 2; ++n) _Pragma("unroll") for (int k = 0; k < 2; ++k) dst[n][k] = *(const PG8_LAS bf16x8*)(lds + PG8_SB(b, h) + boff + n * 2048 + k * 1024); } while (0)
#define PG8_MMA(ai, bj, At, Bt) do { __builtin_amdgcn_s_setprio(1); _Pragma("unroll") for (int m = 0; m < 4; ++m) _Pragma("unroll") for (int n = 0; n < 2; ++n) _Pragma("unroll") for (int k = 0; k < 2; ++k) \
        acc[ai][bj][m][n] = __builtin_amdgcn_mfma_f32_16x16x32_bf16(Bt[n][k], At[m][k], acc[ai][bj][m][n], 0, 0, 0); __builtin_amdgcn_s_setprio(0); } while (0)
#define PG8_WAIT_V(n) asm volatile("s_waitcnt vmcnt(" #n ")" ::: "memory")
#define PG8_WAIT_L(n) asm volatile("s_waitcnt lgkmcnt(" #n ")" ::: "memory")
#define PG8_BAR __builtin_amdgcn_s_barrier()
#define PG8_SCHED __builtin_amdgcn_sched_barrier(0)
    Unit cur, nxt; int ui = 0;
    if (!S.next(0, cur)) return;
    f32x4 acc[2][2][4][2];
#pragma unroll
    for (int a = 0; a < 2; ++a)
#pragma unroll
        for (int b = 0; b < 2; ++b)
#pragma unroll
            for (int m = 0; m < 4; ++m)
#pragma unroll
                for (int n = 0; n < 2; ++n) acc[a][b][m][n] = (f32x4){0.f, 0.f, 0.f, 0.f};
    bf16x8 At[4][2], B0[2][2], B1[2][2];
    const char* cA = (const char*)g.A + (size_t)cur.pm * tstep + (size_t)cur.kt0 * kstep; const char* cB = (const char*)g.Bt + (size_t)cur.pn * tstep + (size_t)cur.kt0 * kstep;
    S.a_ready(cur);
    if constexpr (SP2) {
        PG8_STAGE(PG8_SB(0, 0), cB, voffB); PG8_STAGE(PG8_SB(0, 1), cB + hstep, voffB); PG8_STAGE(PG8_SA(0, 0), cA, voffA); PG8_STAGE(PG8_SA(0, 1), cA + hstep, voffA);
        if (wr == 1) PG8_BAR;
        PG8_WAIT_V(2); PG8_BAR;
        PG8_STAGE(PG8_SB(1, 0), cB + kstep, voffB); PG8_STAGE(PG8_SA(1, 0), cA + kstep, voffA); PG8_STAGE(PG8_SB(1, 1), cB + hstep + kstep, voffB);
        PG8_WAIT_V(6); PG8_BAR;
    } else {
        PG8_STAGE(PG8_SB(0, 0), cB, voffB); PG8_STAGE(PG8_SA(0, 0), cA, voffA); PG8_STAGE(PG8_SB(0, 1), cB + hstep, voffB); PG8_STAGE(PG8_SA(0, 1), cA + hstep, voffA);
        if (wr == 1) PG8_BAR;
        PG8_WAIT_V(4); PG8_BAR;
        PG8_STAGE(PG8_SB(1, 0), cB + kstep, voffB); PG8_STAGE(PG8_SA(1, 0), cA + kstep, voffA); PG8_STAGE(PG8_SB(1, 1), cB + hstep + kstep, voffB);
        PG8_WAIT_V(6); PG8_BAR;
    }
    for (;;) {
        const bool has_next = S.next(ui + 1, nxt);
        const char* nA = has_next ? (const char*)g.A + (size_t)nxt.pm * tstep + (size_t)nxt.kt0 * kstep : cA; const char* nB = has_next ? (const char*)g.Bt + (size_t)nxt.pn * tstep + (size_t)nxt.kt0 * kstep : cB;
        const int nt = cur.nt;
        for (int t = 0; t < nt; t += 2) {
            const bool last = (t == nt - 2);
            const char* a1 = cA + (size_t)(t + 1) * kstep;
            const char* a2 = last ? nA : cA + (size_t)(t + 2) * kstep; const char* b2 = last ? nB : cB + (size_t)(t + 2) * kstep;
            const char* a3 = a2 + kstep; const char* b3 = b2 + kstep;
            if (last && has_next) S.a_ready(nxt);
            if constexpr (SP2) {
            PG8_LDB(B0, 0, 0); PG8_LDB(B1, 0, 1); PG8_SCHED; PG8_LDA(At, 0, 0); PG8_STAGE(PG8_SA(1, 1), a1 + hstep, voffA);
            PG8_WAIT_V(8); PG8_WAIT_L(0); PG8_BAR; PG8_MMA(0, 0, At, B0); PG8_MMA(0, 1, At, B1); PG8_BAR; PG8_SCHED;
            PG8_LDA(At, 0, 1); PG8_STAGE(PG8_SB(0, 0), b2, voffB); PG8_STAGE(PG8_SB(0, 1), b2 + hstep, voffB); PG8_STAGE(PG8_SA(0, 0), a2, voffA);
            PG8_WAIT_V(8); PG8_WAIT_L(0); PG8_BAR; PG8_MMA(1, 0, At, B0); PG8_MMA(1, 1, At, B1); PG8_BAR; PG8_SCHED;
            PG8_LDB(B0, 1, 0); PG8_LDB(B1, 1, 1); PG8_SCHED; PG8_LDA(At, 1, 0); PG8_STAGE(PG8_SA(0, 1), a2 + hstep, voffA);
            PG8_WAIT_V(8); PG8_WAIT_L(0); PG8_BAR; PG8_MMA(0, 0, At, B0); PG8_MMA(0, 1, At, B1); PG8_BAR; PG8_SCHED;
            PG8_LDA(At, 1, 1); PG8_STAGE(PG8_SB(1, 0), b3, voffB); PG8_STAGE(PG8_SB(1, 1), b3 + hstep, voffB); PG8_STAGE(PG8_SA(1, 0), a3, voffA);
            PG8_WAIT_V(8); PG8_WAIT_L(0); PG8_BAR; PG8_MMA(1, 0, At, B0); PG8_MMA(1, 1, At, B1); PG8_BAR; PG8_SCHED;
            } else {
            PG8_LDB(B0, 0, 0); PG8_SCHED; PG8_LDA(At, 0, 0); PG8_STAGE(PG8_SA(1, 1), a1 + hstep, voffA);
            PG8_WAIT_L(8); PG8_BAR; PG8_WAIT_L(0); PG8_MMA(0, 0, At, B0); PG8_BAR; PG8_SCHED;
            PG8_LDB(B1, 0, 1); PG8_STAGE(PG8_SB(0, 0), b2, voffB);
            PG8_BAR; PG8_WAIT_L(0); PG8_MMA(0, 1, At, B1); PG8_BAR;
            PG8_LDA(At, 0, 1); PG8_STAGE(PG8_SA(0, 0), a2, voffA);
            PG8_BAR; PG8_WAIT_L(0); PG8_MMA(1, 0, At, B0); PG8_BAR; PG8_SCHED;
            PG8_STAGE(PG8_SB(0, 1), b2 + hstep, voffB);
            PG8_WAIT_V(6); PG8_BAR; PG8_MMA(1, 1, At, B1); PG8_BAR;
            PG8_LDB(B0, 1, 0); PG8_SCHED; PG8_LDA(At, 1, 0); PG8_STAGE(PG8_SA(0, 1), a2 + hstep, voffA);
            PG8_WAIT_L(8); PG8_BAR; PG8_WAIT_L(0); PG8_MMA(0, 0, At, B0); PG8_BAR; PG8_SCHED;
            PG8_LDB(B1, 1, 1); PG8_STAGE(PG8_SB(1, 0), b3, voffB);
            PG8_BAR; PG8_WAIT_L(0); PG8_MMA(0, 1, At, B1); PG8_BAR;
            PG8_LDA(At, 1, 1); PG8_STAGE(PG8_SA(1, 0), a3, voffA);
            PG8_BAR; PG8_WAIT_L(0); PG8_MMA(1, 0, At, B0); PG8_BAR; PG8_SCHED;
            PG8_STAGE(PG8_SB(1, 1), b3 + hstep, voffB);
            PG8_WAIT_V(6); PG8_BAR; PG8_MMA(1, 1, At, B1); PG8_BAR;
            }
        }
        if constexpr (ALIGN_EPI) { if (wr == 0) PG8_BAR; }
        if constexpr (!Epi::AFTER_DRAIN) { E(acc, cur, wr, wc, fr, fq); S.done(cur); }
        if (!has_next) break;
#pragma unroll
        for (int a = 0; a < 2; ++a)
#pragma unroll
            for (int b = 0; b < 2; ++b)
#pragma unroll
                for (int m = 0; m < 4; ++m)
#pragma unroll
                    for (int n = 0; n < 2; ++n) acc[a][b][m][n] = (f32x4){0.f, 0.f, 0.f, 0.f};
        cur = nxt; cA = nA; cB = nB; ++ui;
        if constexpr (ALIGN_EPI) { if (wr == 1) PG8_BAR; }
    }
    PG8_WAIT_V(0);
    if constexpr (!ALIGN_EPI) { if (wr == 0) PG8_BAR; }
    PG8_BAR;
    if constexpr (Epi::AFTER_DRAIN) { E.fused(acc, cur, wr, wc, fr, fq, lds, wid, lane); S.done(cur); }
#undef PG8_SA
#undef PG8_SB
#undef PG8_STAGE
#undef PG8_LDA
#undef PG8_LDB
#undef PG8_MMA
#undef PG8_WAIT_V
#undef PG8_WAIT_L
#undef PG8_BAR
#undef PG8_SCHED
}
}

#define LAS __attribute__((address_space(3)))
typedef unsigned short bf16_t;
typedef short bf16x8 __attribute__((ext_vector_type(8)));
typedef short s16x4 __attribute__((ext_vector_type(4)));
typedef float f32x4 __attribute__((ext_vector_type(4)));
typedef float f32x2 __attribute__((ext_vector_type(2)));
typedef unsigned u32x4 __attribute__((ext_vector_type(4)));
typedef unsigned u32x2 __attribute__((ext_vector_type(2)));
using pg8::cvt_pk_bf16;

constexpr int NWAVES = 8, NTHREADS = 512;
constexpr int LDS_BYTES = 147456;
constexpr int D = 1024, TP = 16384, TS = 512, T = TP + TS, SEQ = 2048, DFF = 2816, RIN = 6144, VD = 2048;
constexpr int NROPE = SEQ + 4;
constexpr float RMS_EPS = 1e-6f, GN_EPS = 1e-6f;
constexpr size_t OUT_Y = 0, OUT_CONVP = (size_t)T * D, OUT_CONVS = OUT_CONVP + 8 * 2 * D, OUT_RETP = OUT_CONVS + 128 * 2 * D,
                 OUT_RETS = OUT_RETP + (size_t)8 * 4 * 256 * 512, OUT_END = OUT_RETS + (size_t)128 * 4 * 256 * 512;
constexpr size_t al256(size_t x) { return (x + 255) & ~(size_t)255; }
constexpr size_t WS_WCIN = 0;
constexpr size_t WS_WCOUT = WS_WCIN + (size_t)3072 * 1024 * 2;
constexpr size_t WS_WGU0 = WS_WCOUT + (size_t)1024 * 1024 * 2;
constexpr size_t WS_WGU1 = WS_WGU0 + (size_t)5632 * 1024 * 2;
constexpr size_t WS_WD0 = WS_WGU1 + (size_t)5632 * 1024 * 2;
constexpr size_t WS_WD1 = WS_WD0 + (size_t)1024 * 2816 * 2;
constexpr size_t WS_WRIN = WS_WD1 + (size_t)1024 * 2816 * 2;
constexpr size_t WS_WROUT = WS_WRIN + (size_t)6144 * 1024 * 2;
constexpr size_t WS_ROPE = WS_WROUT + (size_t)1024 * 2048 * 2;
constexpr size_t WS_PART = al256(WS_ROPE + (size_t)NROPE * 128 * 8);
constexpr size_t WS_XB = al256(WS_PART + (size_t)T * 16 * 4);
constexpr size_t WS_XRES = WS_XB + (size_t)T * D * 2;
constexpr size_t WS_R = WS_XRES + (size_t)T * D * 4;
constexpr size_t SZ_TD = (size_t)T * D * 2, SZ_TV = (size_t)T * VD * 2;
constexpr size_t WS_BB = WS_R, WS_UB = WS_R + SZ_TD, WS_A2 = WS_R + 2 * SZ_TD;
constexpr size_t WS_HFF = WS_R;
constexpr size_t WS_Q = WS_R, WS_K = WS_Q + SZ_TD, WS_V = WS_K + SZ_TD, WS_G = WS_V + SZ_TV, WS_O = WS_G + SZ_TV, WS_A8 = WS_O + SZ_TV;
constexpr size_t WS_BAR = al256(WS_A8 + SZ_TV), BAR_BYTES = 16384;
constexpr size_t WS_SPLIT = WS_BAR + BAR_BYTES;
constexpr size_t WS_END = WS_SPLIT + (size_t)11 * TS * D * 4;
constexpr int LDS_XB_ST = LDS_BYTES - 64;
static_assert((size_t)T * DFF * 2 <= WS_END - WS_R, "hff fits");


#define XB_TMO      128
#define XB_XCNT(j)  (256  + 64 * (j))
#define XB_XSUB(j)  (1280 + 64 * (j))
#define XB_XGEN(j)  (2304 + 64 * (j))
#define XB_TOP      3328
#define XB_TOPGEN   3392
#define XCD_BAR_WORDS 3456
#define XB_SPIN_CAP (1u << 18)

__device__ __forceinline__ unsigned xb_ld(unsigned* p)              { return __hip_atomic_load(p, __ATOMIC_RELAXED, __HIP_MEMORY_SCOPE_AGENT); }
__device__ __forceinline__ unsigned xb_add(unsigned* p, unsigned v) { return __hip_atomic_fetch_add(p, v, __ATOMIC_RELAXED, __HIP_MEMORY_SCOPE_AGENT); }
__device__ __forceinline__ unsigned xb_xcc_id() { return (unsigned)__builtin_amdgcn_s_getreg((3 << 11) | 20) & 0xFu; }
#define XB_SPIN(cond, bar) do { unsigned _sp = 0; while (cond) { __builtin_amdgcn_s_sleep(1); \
    if ((++_sp & 255u) == 0u) { if (xb_ld(&(bar)[XB_TMO])) break; if (_sp > XB_SPIN_CAP) { atomicAdd(&(bar)[XB_TMO], 1u); break; } } } } while (0)

struct XcdBarrier {
    unsigned* bar; unsigned x;
    volatile LAS unsigned* st;
};

__device__ __forceinline__ XcdBarrier xcd_barrier_post(unsigned* bar, volatile LAS unsigned* st) {
    XcdBarrier b; b.bar = bar; b.x = xb_xcc_id(); b.st = st;
    if (threadIdx.x == 0) (void)xb_add(&bar[XB_XCNT(b.x)], 1u);
    return b;
}
__device__ __forceinline__ void xcd_barrier_complete(unsigned* bar, unsigned x, unsigned& nloc, unsigned& nx) {
    const unsigned G = gridDim.x * gridDim.y * gridDim.z;
    unsigned sum, cnt, mine, sp = 0u;
    for (;;) {
        sum = 0u; cnt = 0u; mine = 0u;
#pragma unroll
        for (unsigned j = 0; j < 16; ++j) { const unsigned c = xb_ld(&bar[XB_XCNT(j)]); sum += c; cnt += (c > 0u) ? 1u : 0u; mine = (j == x) ? c : mine; }
        if (sum == G) break;
        __builtin_amdgcn_s_sleep(1);
        if ((++sp & 255u) == 0u) { if (xb_ld(&bar[XB_TMO])) break; if (sp > XB_SPIN_CAP) { atomicAdd(&bar[XB_TMO], 1u); break; } }
    }
    nloc = mine > 0u ? mine : 1u; nx = cnt > 0u ? cnt : 1u;
}

__device__ __forceinline__ void xcd_barrier(const XcdBarrier& b) {
    asm volatile("s_waitcnt vmcnt(0)" ::: "memory");
    __syncthreads();
    if (threadIdx.x == 0) {
        unsigned* bar = b.bar;
        __builtin_amdgcn_s_waitcnt(0);
        unsigned nloc = b.st[0], nx = b.st[1];
        if (nloc == 0u) { xcd_barrier_complete(bar, b.x, nloc, nx); b.st[0] = nloc; b.st[1] = nx; }
        const unsigned old = xb_add(&bar[XB_XSUB(b.x)], 1u);
        const unsigned gen = old / nloc;
        if (old + 1u == (gen + 1u) * nloc) {
            __builtin_amdgcn_fence(__ATOMIC_RELEASE, "agent");
            asm volatile("s_waitcnt vmcnt(0)" ::: "memory");
            const unsigned og = xb_add(&bar[XB_TOP], 1u);
            const unsigned tg = og / nx;
            if (og + 1u == (tg + 1u) * nx) xb_add(&bar[XB_TOPGEN], 1u);
            else XB_SPIN(xb_ld(&bar[XB_TOPGEN]) == tg, bar);
            __builtin_amdgcn_fence(__ATOMIC_ACQUIRE, "agent");
            xb_add(&bar[XB_XGEN(b.x)], 1u);
            asm volatile("s_waitcnt vmcnt(0)" ::: "memory");
        } else {
            XB_SPIN(xb_ld(&bar[XB_XGEN(b.x)]) == gen, bar);
            __builtin_amdgcn_fence(__ATOMIC_ACQUIRE, "agent");
            asm volatile("s_waitcnt vmcnt(0)" ::: "memory");
        }
    }
    __syncthreads();
}

static_assert(XCD_BAR_WORDS * 4 <= BAR_BYTES, "barrier words");
struct Params { const float* in[16]; float* out; unsigned char* ws; int ph_lo, ph_hi; };

__device__ __forceinline__ float wave_sum(float v) {
#pragma unroll
    for (int o = 1; o < 64; o <<= 1) v += __shfl_xor(v, o);
    return v;
}
__device__ __forceinline__ float silu_f(float x) { return x * __builtin_amdgcn_rcpf(1.0f + __expf(-x)); }
__device__ __forceinline__ float bf2f(unsigned short b) { return __builtin_bit_cast(float, (unsigned)b << 16); }
__device__ __forceinline__ float bflo(unsigned w) { return __builtin_bit_cast(float, w << 16); }
__device__ __forceinline__ float bfhi(unsigned w) { return __builtin_bit_cast(float, w & 0xffff0000u); }
__device__ __forceinline__ u32x4 pack8(const f32x4 a, const f32x4 b) { u32x4 w; w.x = cvt_pk_bf16(a[0], a[1]); w.y = cvt_pk_bf16(a[2], a[3]); w.z = cvt_pk_bf16(b[0], b[1]); w.w = cvt_pk_bf16(b[2], b[3]); return w; }
__device__ __forceinline__ float row_rs(const float* part, int row) {
    const f32x4* p = (const f32x4*)(part + (size_t)row * 16);
    const f32x4 a = p[0], b = p[1], c = p[2], d = p[3];
    const float s = (((a[0] + a[1]) + (a[2] + a[3])) + ((b[0] + b[1]) + (b[2] + b[3]))) + (((c[0] + c[1]) + (c[2] + c[3])) + ((d[0] + d[1]) + (d[2] + d[3])));
    return rsqrtf(s * (1.0f / D) + RMS_EPS);
}

typedef f32x4 Acc[2][2][4][2];

struct EpiConvIn {
    static constexpr bool PERM = true, AFTER_DRAIN = false;
    const float* part; bf16_t* bb; bf16_t* ub; float* convp; float* convs;
    __device__ __forceinline__ void operator()(const Acc& acc, const pg8::Unit& u, int wr, int wc, int fr, int fq) const {
#pragma unroll
        for (int ai = 0; ai < 2; ++ai)
#pragma unroll
            for (int m = 0; m < 4; ++m) {
                const int row = u.pm * 256 + ai * 128 + wr * 64 + m * 16 + fr;
                const float rs = row_rs(part, row);
                if (u.pn < 4) {
#pragma unroll
                    for (int bj = 0; bj < 2; ++bj) { const int col = u.pn * 256 + bj * 128 + wc * 32 + 8 * fq;
                        *(u32x4*)(bb + (size_t)row * D + col) = pack8(acc[ai][bj][m][0] * rs, acc[ai][bj][m][1] * rs); }
                } else {
                    const int col = (u.pn - 4) * 128 + wc * 32 + 8 * fq;
                    const f32x4 u0 = (acc[ai][0][m][0] * rs) * (acc[ai][1][m][0] * rs), u1 = (acc[ai][0][m][1] * rs) * (acc[ai][1][m][1] * rs);
                    *(u32x4*)(ub + (size_t)row * D + col) = pack8(u0, u1);
                    float* dst = nullptr;
                    if (row < TP) { const int l = row & (SEQ - 1); if (l >= SEQ - 2) dst = convp + ((size_t)(row >> 11) * 2 + (l - (SEQ - 2))) * D + col; }
                    else { const int ts = row - TP, l = ts & 3; if (l >= 2) dst = convs + ((size_t)(ts >> 2) * 2 + (l - 2)) * D + col; }
                    if (dst) { *(f32x4*)dst = u0; *(f32x4*)(dst + 4) = u1; }
                }
            }
    }
};

template <int MODE> struct EpiResid {
    static constexpr bool PERM = true, AFTER_DRAIN = false;
    const float* xp; const float* xs; float* xres; bf16_t* xb; float* part; float* split;
    __device__ __forceinline__ void operator()(const Acc& acc, const pg8::Unit& u, int wr, int wc, int fr, int fq) const {
        if (u.pm >= TP / 256) {
#pragma unroll
            for (int ai = 0; ai < 2; ++ai)
#pragma unroll
                for (int m = 0; m < 4; ++m) {
                    const int row = u.pm * 256 + ai * 128 + wr * 64 + m * 16 + fr;
#pragma unroll
                    for (int bj = 0; bj < 2; ++bj) { float* dst = split + ((size_t)(u.kt0 >> 2) * TS + (row - TP)) * D + u.pn * 256 + bj * 128 + wc * 32 + 8 * fq;
                        *(f32x4*)dst = acc[ai][bj][m][0]; *(f32x4*)(dst + 4) = acc[ai][bj][m][1]; }
                }
            return;
        }
#pragma unroll
        for (int ai = 0; ai < 2; ++ai)
#pragma unroll
            for (int m = 0; m < 4; ++m) {
                const int row = u.pm * 256 + ai * 128 + wr * 64 + m * 16 + fr;
                const float* src = row < TP ? xp + (size_t)row * D : xs + (size_t)(row - TP) * D;
                float ss = 0.f;
#pragma unroll
                for (int bj = 0; bj < 2; ++bj) { const int col = u.pn * 256 + bj * 128 + wc * 32 + 8 * fq;
                    f32x4 r0, r1;
                    if (MODE == 0) { r0 = *(const f32x4*)(src + col); r1 = *(const f32x4*)(src + col + 4); }
                    else { const u32x4 w = *(const u32x4*)(xb + (size_t)row * D + col); r0 = (f32x4){bflo(w.x), bfhi(w.x), bflo(w.y), bfhi(w.y)}; r1 = (f32x4){bflo(w.z), bfhi(w.z), bflo(w.w), bfhi(w.w)}; }
                    const f32x4 v0 = acc[ai][bj][m][0] + r0, v1 = acc[ai][bj][m][1] + r1;
                    *(u32x4*)(xb + (size_t)row * D + col) = pack8(v0, v1);
                    if (MODE != 2) {
                        ss += ((v0[0] * v0[0] + v0[1] * v0[1]) + (v0[2] * v0[2] + v0[3] * v0[3])) + ((v1[0] * v1[0] + v1[1] * v1[1]) + (v1[2] * v1[2] + v1[3] * v1[3])); } }
                if (MODE != 2) { ss += __shfl_xor(ss, 16); ss += __shfl_xor(ss, 32);
                    if (fq == 0) part[(size_t)row * 16 + u.pn * 4 + wc] = ss; }
            }
    }
};

struct EpiSwiGLU {
    static constexpr bool PERM = true, AFTER_DRAIN = false;
    const float* part; bf16_t* hff;
    __device__ __forceinline__ void operator()(const Acc& acc, const pg8::Unit& u, int wr, int wc, int fr, int fq) const {
#pragma unroll
        for (int ai = 0; ai < 2; ++ai)
#pragma unroll
            for (int m = 0; m < 4; ++m) {
                const int row = u.pm * 256 + ai * 128 + wr * 64 + m * 16 + fr;
                const float rs = row_rs(part, row);
                const int col = u.pn * 128 + wc * 32 + 8 * fq;
                f32x4 h[2];
#pragma unroll
                for (int n = 0; n < 2; ++n)
#pragma unroll
                    for (int e = 0; e < 4; ++e) h[n][e] = silu_f(acc[ai][0][m][n][e] * rs) * (acc[ai][1][m][n][e] * rs);
                *(u32x4*)(hff + (size_t)row * DFF + col) = pack8(h[0], h[1]);
            }
    }
};

struct EpiRetIn {
    static constexpr bool PERM = true, AFTER_DRAIN = false;
    const float* part; const float* rope; bf16_t* Q; bf16_t* K; bf16_t* V; bf16_t* G;
    __device__ __forceinline__ void operator()(const Acc& acc, const pg8::Unit& u, int wr, int wc, int fr, int fq) const {
#pragma unroll
        for (int ai = 0; ai < 2; ++ai)
#pragma unroll
            for (int m = 0; m < 4; ++m) {
                const int row = u.pm * 256 + ai * 128 + wr * 64 + m * 16 + fr;
                const float rs = row_rs(part, row);
                if (u.pn < 8) {
                    const int pidx = row < TP ? (row & (SEQ - 1)) : SEQ + ((row - TP) & 3);
                    const int i0 = wc * 32 + 8 * fq;
                    const f32x4* cs = (const f32x4*)(rope + ((size_t)pidx * 128 + i0) * 2);
                    const float sc = (u.pn < 4) ? rs : rs * 0.0625f;
                    f32x4 o1[2], o2[2];
#pragma unroll
                    for (int n = 0; n < 2; ++n) { const f32x4 c01 = cs[2 * n], c23 = cs[2 * n + 1];
                        const f32x4 x1 = acc[ai][0][m][n] * sc, x2 = acc[ai][1][m][n] * sc;
                        const f32x4 cc = (f32x4){c01[0], c01[2], c23[0], c23[2]}, sn = (f32x4){c01[1], c01[3], c23[1], c23[3]};
                        o1[n] = x1 * cc - x2 * sn; o2[n] = x1 * sn + x2 * cc; }
                    bf16_t* dst = (u.pn < 4 ? Q : K) + (size_t)row * D + (u.pn & 3) * 256 + i0;
                    *(u32x4*)dst = pack8(o1[0], o1[1]); *(u32x4*)(dst + 128) = pack8(o2[0], o2[1]);
                } else if (u.pn < 16) {
#pragma unroll
                    for (int bj = 0; bj < 2; ++bj) { const int col = (u.pn - 8) * 256 + bj * 128 + wc * 32 + 8 * fq;
                        *(u32x4*)(V + (size_t)row * VD + col) = pack8(acc[ai][bj][m][0] * rs, acc[ai][bj][m][1] * rs); }
                } else {
#pragma unroll
                    for (int bj = 0; bj < 2; ++bj) { const int col = (u.pn - 16) * 256 + bj * 128 + wc * 32 + 8 * fq;
                        f32x4 g[2];
#pragma unroll
                        for (int n = 0; n < 2; ++n)
#pragma unroll
                            for (int e = 0; e < 4; ++e) g[n][e] = silu_f(acc[ai][bj][m][n][e] * rs);
                        *(u32x4*)(G + (size_t)row * VD + col) = pack8(g[0], g[1]); }
                }
            }
    }
};

__device__ __forceinline__ void transpose_item(const float* W, int K, int N, const float* gain, bf16_t* WT, int kind, LAS float* scr, int item, int lane) {
    const int nblk = N / 32, kb = item / nblk, nb = item % nblk, k0 = 64 * kb, n0 = 32 * nb;
    int drow;
    if (kind == 0) drow = n0;
    else if (kind == 1) { if (n0 < 1024) drow = n0; else { const int hh = (n0 - 1024) >> 10, j = (n0 - 1024) & 1023; drow = 1024 + (j >> 7) * 256 + hh * 128 + (j & 127); } }
    else if (kind == 2) drow = (n0 >> 7) * 256 + (n0 & 127);
    else drow = (n0 >> 7) * 256 + 128 + (n0 & 127);
    { const int kq = lane >> 3, n4 = (lane & 7) * 4;
        f32x4 v[8];
#pragma unroll
        for (int i = 0; i < 8; ++i) v[i] = __builtin_nontemporal_load((const f32x4*)(W + (size_t)(k0 + kq + 8 * i) * N + n0 + n4));
        if (gain) {
#pragma unroll
            for (int i = 0; i < 8; ++i) v[i] = v[i] * gain[k0 + kq + 8 * i]; }
#pragma unroll
        for (int i = 0; i < 8; ++i) { LAS float* d = scr + (kq + 8 * i) * 33 + n4; d[0] = v[i][0]; d[1] = v[i][1]; d[2] = v[i][2]; d[3] = v[i][3]; } }
    asm volatile("s_waitcnt lgkmcnt(0)" ::: "memory");
    const int c = lane & 7;
#pragma unroll
    for (int j = 0; j < 4; ++j) { const int n = (lane >> 3) + 8 * j; const LAS float* s = scr + (8 * c) * 33 + n;
        u32x4 o; o.x = cvt_pk_bf16(s[0 * 33], s[1 * 33]); o.y = cvt_pk_bf16(s[2 * 33], s[3 * 33]); o.z = cvt_pk_bf16(s[4 * 33], s[5 * 33]); o.w = cvt_pk_bf16(s[6 * 33], s[7 * 33]);
        *(u32x4*)(WT + (size_t)(drow + n) * K + k0 + 8 * c) = o; }
    asm volatile("s_waitcnt lgkmcnt(0)" ::: "memory");
}

__device__ __forceinline__ void transpose_group(const Params& p, LAS unsigned char* lds, int grp, int gw, int NGW) {
    const int lane = threadIdx.x & 63, wave = __builtin_amdgcn_readfirstlane(threadIdx.x >> 6);
    LAS float* scr = (LAS float*)(lds + wave * 16384);
    unsigned char* ws = p.ws;
    constexpr int I_CIN = 16 * 96, I_COUT = 16 * 32, I_G = 16 * 88, I_D = 44 * 32, I_RIN = 16 * 192, I_ROUT = 32 * 32;
    if (grp == 0) {
        for (int r = gw; r < I_CIN; r += NGW) transpose_item(p.in[6], 1024, 3072, p.in[4], (bf16_t*)(ws + WS_WCIN), 1, scr, r, lane);
    } else if (grp == 1) {
        for (int it = gw; it < I_COUT + 2 * I_G + I_D; it += NGW) { int r = it;
            if (r < I_COUT) { transpose_item(p.in[8], 1024, 1024, nullptr, (bf16_t*)(ws + WS_WCOUT), 0, scr, r, lane); continue; } r -= I_COUT;
            if (r < I_G) { transpose_item(p.in[12], 1024, DFF, p.in[5], (bf16_t*)(ws + WS_WGU0), 2, scr, r, lane); continue; } r -= I_G;
            if (r < I_G) { transpose_item(p.in[13], 1024, DFF, p.in[5], (bf16_t*)(ws + WS_WGU0), 3, scr, r, lane); continue; } r -= I_G;
            transpose_item(p.in[14], DFF, 1024, nullptr, (bf16_t*)(ws + WS_WD0), 0, scr, r, lane); }
    } else if (grp == 2) {
        for (int r = gw; r < I_RIN; r += NGW) transpose_item(p.in[9], 1024, RIN, p.in[4] + D, (bf16_t*)(ws + WS_WRIN), 0, scr, r, lane);
    } else {
        for (int it = gw; it < I_ROUT + 2 * I_G + I_D; it += NGW) { int r = it;
            if (r < I_ROUT) { transpose_item(p.in[11], VD, 1024, p.in[10], (bf16_t*)(ws + WS_WROUT), 0, scr, r, lane); continue; } r -= I_ROUT;
            if (r < I_G) { transpose_item(p.in[12] + (size_t)1024 * DFF, 1024, DFF, p.in[5] + D, (bf16_t*)(ws + WS_WGU1), 2, scr, r, lane); continue; } r -= I_G;
            if (r < I_G) { transpose_item(p.in[13] + (size_t)1024 * DFF, 1024, DFF, p.in[5] + D, (bf16_t*)(ws + WS_WGU1), 3, scr, r, lane); continue; } r -= I_G;
            transpose_item(p.in[14] + (size_t)DFF * 1024, DFF, 1024, nullptr, (bf16_t*)(ws + WS_WD1), 0, scr, r, lane); }
    }
}
__device__ __forceinline__ void idle_slot_transposes(const Params& p, LAS unsigned char* lds, int grp, int nwg, int G, int bx) {
    if (G != 256) return;
    const int R = (nwg + G - 1) / G, busy = nwg - (R - 1) * G;
    if (bx < busy) return;
    const int wave = __builtin_amdgcn_readfirstlane(threadIdx.x >> 6);
    transpose_group(p, lds, grp, (bx - busy) * NWAVES + wave, (G - busy) * NWAVES);
}
__device__ __forceinline__ void phase_prologue(const Params& p, LAS unsigned char* lds, int vcu, int G) {
    const int tid = threadIdx.x, lane = tid & 63, wave = __builtin_amdgcn_readfirstlane(tid >> 6);
    LAS float* scr = (LAS float*)(lds + wave * 16384);
    const int gw = vcu * NWAVES + wave, NGW = G * NWAVES;
    unsigned char* ws = p.ws;
    if (G == 256) transpose_group(p, lds, 0, gw, NGW);
    else { for (int grp = 0; grp < 4; ++grp) transpose_group(p, lds, grp, gw, NGW); }
    bf16_t* xb = (bf16_t*)(ws + WS_XB); float* part = (float*)(ws + WS_PART);
    for (int rowb = gw * 2; rowb < T; rowb += NGW * 2) {
      f32x4 xv[2][4];
#pragma unroll
      for (int k = 0; k < 2; ++k) { const int row = rowb + k; const float* xr = row < TP ? p.in[0] + (size_t)row * D : p.in[1] + (size_t)(row - TP) * D;
#pragma unroll
        for (int j = 0; j < 2; ++j) { xv[k][2 * j] = __builtin_nontemporal_load((const f32x4*)(xr + j * 512 + lane * 8)); xv[k][2 * j + 1] = __builtin_nontemporal_load((const f32x4*)(xr + j * 512 + lane * 8 + 4)); } }
#pragma unroll
      for (int k = 0; k < 2; ++k) { const int row = rowb + k; const float* xr = row < TP ? p.in[0] + (size_t)row * D : p.in[1] + (size_t)(row - TP) * D;
        float ss = 0.f;
#pragma unroll
        for (int j = 0; j < 2; ++j) { const int col = j * 512 + lane * 8;
            const f32x4 v0 = xv[k][2 * j], v1 = xv[k][2 * j + 1];
            *(u32x4*)(xb + (size_t)row * D + col) = pack8(v0, v1);
            ss += ((v0[0] * v0[0] + v0[1] * v0[1]) + (v0[2] * v0[2] + v0[3] * v0[3])) + ((v1[0] * v1[0] + v1[1] * v1[1]) + (v1[2] * v1[2] + v1[3] * v1[3])); }
        ss = wave_sum(ss);
        if (lane < 16) part[(size_t)row * 16 + lane] = (lane == 0) ? ss : 0.f;
    } }
    float* rope = (float*)(ws + WS_ROPE);
    for (int e = vcu * NTHREADS + tid; e < NROPE * 128; e += G * NTHREADS) {
        const int pi = e >> 7, i = e & 127;
        const double pos = pi < SEQ ? (double)pi : (double)(16384 + (pi - SEQ));
        const double inv = exp2(-(double)i * (13.287712379549449 / 128.0));
        const double ang = pos * inv;
        const double n = rint(ang * 0.15915494309189535);
        const float r = (float)(ang - n * 6.283185307179586);
        rope[2 * e] = __cosf(r); rope[2 * e + 1] = __sinf(r);
    }
}

__device__ __forceinline__ void unpack8(const u32x4 w, float* f) { f[0] = bflo(w.x); f[1] = bfhi(w.x); f[2] = bflo(w.y); f[3] = bfhi(w.y); f[4] = bflo(w.z); f[5] = bfhi(w.z); f[6] = bflo(w.w); f[7] = bfhi(w.w); }
__device__ __forceinline__ void phase_conv_sample(const Params& p, int vcu, int G) {
    unsigned char* ws = p.ws;
    const bf16_t* bb = (const bf16_t*)(ws + WS_BB); const bf16_t* ub = (const bf16_t*)(ws + WS_UB); bf16_t* a2 = (bf16_t*)(ws + WS_A2);
    const float* cw = p.in[7]; const float* sc = p.in[2];
    for (int it = TP * 128 + vcu * NTHREADS + threadIdx.x; it < T * 128; it += G * NTHREADS) {
        const int row = it >> 7, col = (it & 127) * 8;
        float b[8], u0[8], u1[8], u2[8];
        unpack8(*(const u32x4*)(bb + (size_t)row * D + col), b);
        unpack8(*(const u32x4*)(ub + (size_t)row * D + col), u2);
        int l; const float* buf = nullptr;
        if (row < TP) l = row & (SEQ - 1); else { const int ts = row - TP; l = ts & 3; buf = sc + (size_t)(ts >> 2) * 2 * D + col; }
        if (l >= 1) unpack8(*(const u32x4*)(ub + (size_t)(row - 1) * D + col), u1);
        else if (buf) { const f32x4 a = *(const f32x4*)(buf + D), c = *(const f32x4*)(buf + D + 4); u1[0] = a[0]; u1[1] = a[1]; u1[2] = a[2]; u1[3] = a[3]; u1[4] = c[0]; u1[5] = c[1]; u1[6] = c[2]; u1[7] = c[3]; }
        else {
#pragma unroll
            for (int e = 0; e < 8; ++e) u1[e] = 0.f; }
        if (l >= 2) unpack8(*(const u32x4*)(ub + (size_t)(row - 2) * D + col), u0);
        else if (buf) { const float* q = buf + (size_t)l * D; const f32x4 a = *(const f32x4*)q, c = *(const f32x4*)(q + 4); u0[0] = a[0]; u0[1] = a[1]; u0[2] = a[2]; u0[3] = a[3]; u0[4] = c[0]; u0[5] = c[1]; u0[6] = c[2]; u0[7] = c[3]; }
        else {
#pragma unroll
            for (int e = 0; e < 8; ++e) u0[e] = 0.f; }
        f32x4 o[2];
#pragma unroll
        for (int e = 0; e < 8; ++e) { const float y = cw[col + e] * u0[e] + cw[D + col + e] * u1[e] + cw[2 * D + col + e] * u2[e]; o[e >> 2][e & 3] = b[e] * y; }
        *(u32x4*)(a2 + (size_t)row * D + col) = pack8(o[0], o[1]);
    }
}

__device__ __forceinline__ void phase_conv(const Params& p, int vcu, int G) {
    unsigned char* ws = p.ws;
    const bf16_t* bb = (const bf16_t*)(ws + WS_BB); const bf16_t* ub = (const bf16_t*)(ws + WS_UB); bf16_t* a2 = (bf16_t*)(ws + WS_A2);
    const float* cw = p.in[7];
    const int col = (threadIdx.x & 127) * 8;
    float w0[8], w1[8], w2[8];
#pragma unroll
    for (int e = 0; e < 8; ++e) { w0[e] = cw[col + e]; w1[e] = cw[D + col + e]; w2[e] = cw[2 * D + col + e]; }
    const int rstride = G * 4;
    for (int r0 = vcu * 4 + (threadIdx.x >> 7); r0 < TP; r0 += 4 * rstride) {
        u32x4 vb[4], v2[4], v1[4], v0[4];
#pragma unroll
        for (int k = 0; k < 4; ++k) { const int row = r0 + k * rstride; if (row < TP) { const int l = row & (SEQ - 1);
            vb[k] = __builtin_nontemporal_load((const u32x4*)(bb + (size_t)row * D + col)); v2[k] = *(const u32x4*)(ub + (size_t)row * D + col);
            v1[k] = *(const u32x4*)(ub + (size_t)(row - (l >= 1 ? 1 : 0)) * D + col); v0[k] = *(const u32x4*)(ub + (size_t)(row - (l >= 2 ? 2 : 0)) * D + col); } }
#pragma unroll
        for (int k = 0; k < 4; ++k) { const int row = r0 + k * rstride; if (row < TP) { const int l = row & (SEQ - 1);
            float b[8], u0[8], u1[8], u2[8]; unpack8(vb[k], b); unpack8(v2[k], u2); unpack8(v1[k], u1); unpack8(v0[k], u0);
            const float m1 = l >= 1 ? 1.f : 0.f, m0 = l >= 2 ? 1.f : 0.f;
            f32x4 o[2];
#pragma unroll
            for (int e = 0; e < 8; ++e) { const float y = w0[e] * (u0[e] * m0) + w1[e] * (u1[e] * m1) + w2[e] * u2[e]; o[e >> 2][e & 3] = b[e] * y; }
            __builtin_nontemporal_store(pack8(o[0], o[1]), (u32x4*)(a2 + (size_t)row * D + col)); } }
    }
    phase_conv_sample(p, vcu, G);
}

__device__ __forceinline__ bf16x8 tr_read2(LAS const unsigned char* a0, LAS const unsigned char* a1) {
    const s16x4 a = __builtin_amdgcn_ds_read_tr16_b64_v4i16((LAS s16x4*)a0);
    const s16x4 b = __builtin_amdgcn_ds_read_tr16_b64_v4i16((LAS s16x4*)a1);
    return (bf16x8){a[0], a[1], a[2], a[3], b[0], b[1], b[2], b[3]};
}
constexpr int KS_STRIDE = 528, VS_STRIDE = 144, ST_STRIDE = 528;
constexpr int LDS_KS = 0, LDS_VS = LDS_KS + 128 * KS_STRIDE, LDS_VW = LDS_VS + 128 * VS_STRIDE, LDS_ST = LDS_VW + 128 * VS_STRIDE, LDS_RET_END = LDS_ST + 64 * ST_STRIDE;
static_assert(LDS_RET_END <= LDS_BYTES, "retention LDS");

__device__ __forceinline__ void retention_prompt_unit(const Params& p, LAS unsigned char* lds, int unit) {
    const int tid = threadIdx.x, lane = tid & 63, wid = __builtin_amdgcn_readfirstlane(tid >> 6), fr = lane & 15, fq = lane >> 4;
    const int b = unit >> 5, h = (unit >> 3) & 3, vb = unit & 7;
    unsigned char* ws = p.ws;
    const bf16_t* Qg = (const bf16_t*)(ws + WS_Q) + (size_t)b * SEQ * D + h * 256;
    const bf16_t* Kg = (const bf16_t*)(ws + WS_K) + (size_t)b * SEQ * D + h * 256;
    const bf16_t* Vg = (const bf16_t*)(ws + WS_V) + (size_t)b * SEQ * VD + h * 512 + vb * 64;
    bf16_t* Og = (bf16_t*)(ws + WS_O) + (size_t)b * SEQ * VD + h * 512 + vb * 64;
    const float log2g = __log2f(1.0f - exp2f(-5.0f - (float)h));
    const float gC = exp2f(128.0f * log2g);
    f32x4 S[2][4];
#pragma unroll
    for (int mt = 0; mt < 2; ++mt)
#pragma unroll
        for (int nt = 0; nt < 4; ++nt) S[mt][nt] = (f32x4){0.f, 0.f, 0.f, 0.f};
    LAS unsigned char* Ks = lds + LDS_KS; LAS unsigned char* Vs = lds + LDS_VS; LAS unsigned char* Vw = lds + LDS_VW; LAS unsigned char* St = lds + LDS_ST;
    for (int c = 0; c < 16; ++c) {
        __syncthreads();
#pragma unroll
        for (int mt = 0; mt < 2; ++mt)
#pragma unroll
            for (int nt = 0; nt < 4; ++nt) { u32x2 w; w.x = cvt_pk_bf16(S[mt][nt][0], S[mt][nt][1]); w.y = cvt_pk_bf16(S[mt][nt][2], S[mt][nt][3]);
                *(LAS u32x2*)(St + (nt * 16 + fr) * ST_STRIDE + (32 * wid + 16 * mt + fq * 4) * 2) = w; }
#pragma unroll
        for (int i = 0; i < 8; ++i) { const int id = tid + i * NTHREADS, row = id >> 5, cc = id & 31;
            *(LAS u32x4*)(Ks + row * KS_STRIDE + cc * 16) = *(const u32x4*)(Kg + (size_t)(c * 128 + row) * D + cc * 8); }
#pragma unroll
        for (int i = 0; i < 2; ++i) { const int id = tid + i * NTHREADS, row = id >> 3, cc = id & 7;
            const u32x4 v = *(const u32x4*)(Vg + (size_t)(c * 128 + row) * VD + cc * 8);
            *(LAS u32x4*)(Vs + row * VS_STRIDE + cc * 16) = v;
            const float sw = exp2f((float)(127 - row) * log2g);
            u32x4 w; w.x = cvt_pk_bf16(bflo(v.x) * sw, bfhi(v.x) * sw); w.y = cvt_pk_bf16(bflo(v.y) * sw, bfhi(v.y) * sw); w.z = cvt_pk_bf16(bflo(v.z) * sw, bfhi(v.z) * sw); w.w = cvt_pk_bf16(bflo(v.w) * sw, bfhi(v.w) * sw);
            *(LAS u32x4*)(Vw + row * VS_STRIDE + cc * 16) = w; }
        bf16x8 qf[8];
#pragma unroll
        for (int ks = 0; ks < 8; ++ks) qf[ks] = *(const bf16x8*)(Qg + (size_t)(c * 128 + 16 * wid + fr) * D + ks * 32 + fq * 8);
        __syncthreads();
        f32x4 sc[8];
#pragma unroll
        for (int jt = 0; jt < 8; ++jt) {
            sc[jt] = (f32x4){0.f, 0.f, 0.f, 0.f};
            if (jt <= wid) {
#pragma unroll
                for (int ks = 0; ks < 8; ++ks) { const bf16x8 kf = *(const LAS bf16x8*)(Ks + (jt * 16 + fr) * KS_STRIDE + ks * 64 + fq * 16);
                    sc[jt] = __builtin_amdgcn_mfma_f32_16x16x32_bf16(kf, qf[ks], sc[jt], 0, 0, 0); }
#pragma unroll
                for (int r = 0; r < 4; ++r) { const int dij = 16 * (wid - jt) + fr - fq * 4 - r;
                    sc[jt][r] = dij >= 0 ? sc[jt][r] * exp2f((float)dij * log2g) : 0.f; }
            }
        }
        f32x4 o[4];
#pragma unroll
        for (int nt = 0; nt < 4; ++nt) {
            o[nt] = (f32x4){0.f, 0.f, 0.f, 0.f};
#pragma unroll
            for (int ks = 0; ks < 8; ++ks) { const bf16x8 sf = *(const LAS bf16x8*)(St + (nt * 16 + fr) * ST_STRIDE + ks * 64 + fq * 16);
                o[nt] = __builtin_amdgcn_mfma_f32_16x16x32_bf16(qf[ks], sf, o[nt], 0, 0, 0); }
#pragma unroll
            for (int r = 0; r < 4; ++r) o[nt][r] *= exp2f((float)(16 * wid + fq * 4 + r + 1) * log2g);
        }
#pragma unroll
        for (int a = 0; a < 4; ++a) {
            if (2 * a <= wid) {
                bf16x8 pa; { const unsigned w0 = cvt_pk_bf16(sc[2 * a][0], sc[2 * a][1]), w1 = cvt_pk_bf16(sc[2 * a][2], sc[2 * a][3]), w2 = cvt_pk_bf16(sc[2 * a + 1][0], sc[2 * a + 1][1]), w3 = cvt_pk_bf16(sc[2 * a + 1][2], sc[2 * a + 1][3]);
                    const u32x4 w = (u32x4){w0, w1, w2, w3}; pa = __builtin_bit_cast(bf16x8, w); }
#pragma unroll
                for (int nt = 0; nt < 4; ++nt) {
                    LAS const unsigned char* a0 = Vs + (32 * a + fq * 4 + (fr >> 2)) * VS_STRIDE + (nt * 16 + 4 * (fr & 3)) * 2;
                    const bf16x8 vf = tr_read2(a0, a0 + 16 * VS_STRIDE);
                    o[nt] = __builtin_amdgcn_mfma_f32_16x16x32_bf16(pa, vf, o[nt], 0, 0, 0); }
            }
        }
#pragma unroll
        for (int nt = 0; nt < 4; ++nt)
#pragma unroll
            for (int r = 0; r < 4; ++r) Og[(size_t)(c * 128 + 16 * wid + fq * 4 + r) * VD + nt * 16 + fr] = (bf16_t)(cvt_pk_bf16(o[nt][r], 0.f) & 0xffffu);
#pragma unroll
        for (int mt = 0; mt < 2; ++mt)
#pragma unroll
            for (int nt = 0; nt < 4; ++nt) S[mt][nt] = S[mt][nt] * gC;
#pragma unroll
        for (int ks = 0; ks < 4; ++ks) {
            bf16x8 af[2];
#pragma unroll
            for (int mt = 0; mt < 2; ++mt) { LAS const unsigned char* a0 = Ks + (ks * 32 + fq * 8 + (fr >> 2)) * KS_STRIDE + (32 * wid + 16 * mt + 4 * (fr & 3)) * 2;
                af[mt] = tr_read2(a0, a0 + 4 * KS_STRIDE); }
#pragma unroll
            for (int nt = 0; nt < 4; ++nt) { LAS const unsigned char* b0 = Vw + (ks * 32 + fq * 8 + (fr >> 2)) * VS_STRIDE + (nt * 16 + 4 * (fr & 3)) * 2;
                const bf16x8 bfr = tr_read2(b0, b0 + 4 * VS_STRIDE);
#pragma unroll
                for (int mt = 0; mt < 2; ++mt) S[mt][nt] = __builtin_amdgcn_mfma_f32_16x16x32_bf16(af[mt], bfr, S[mt][nt], 0, 0, 0); }
        }
    }
    float* So = p.out + OUT_RETP + ((size_t)(b * 4 + h) * 256) * 512 + vb * 64;
#pragma unroll
    for (int mt = 0; mt < 2; ++mt)
#pragma unroll
        for (int nt = 0; nt < 4; ++nt)
#pragma unroll
            for (int r = 0; r < 4; ++r) So[(size_t)(32 * wid + 16 * mt + fq * 4 + r) * 512 + nt * 16 + fr] = S[mt][nt][r];
}

constexpr int LDS_SQ = 0, LDS_SK = 4096, LDS_SA = 8192, LDS_SRED = 8448;
__device__ __forceinline__ void retention_sample_unit(const Params& p, LAS unsigned char* lds, int unit) {
    const int tid = threadIdx.x, lane = tid & 63, wid = __builtin_amdgcn_readfirstlane(tid >> 6);
    const int s = unit >> 2, h = unit & 3, t0 = TP + s * 4;
    unsigned char* ws = p.ws;
    const bf16_t* Qg = (const bf16_t*)(ws + WS_Q) + (size_t)t0 * D + h * 256;
    const bf16_t* Kg = (const bf16_t*)(ws + WS_K) + (size_t)t0 * D + h * 256;
    const bf16_t* Vg = (const bf16_t*)(ws + WS_V) + (size_t)t0 * VD + h * 512;
    bf16_t* Og = (bf16_t*)(ws + WS_O) + (size_t)t0 * VD + h * 512;
    const float g = 1.0f - exp2f(-5.0f - (float)h), g2 = g * g, g3 = g2 * g, g4 = g2 * g2;
    LAS f32x4* qs = (LAS f32x4*)(lds + LDS_SQ); LAS f32x4* kws = (LAS f32x4*)(lds + LDS_SK); LAS float* asc = (LAS float*)(lds + LDS_SA); LAS float* red = (LAS float*)(lds + LDS_SRED);
    __syncthreads();
    if (tid < 256) { const int d = tid;
        qs[d] = (f32x4){bf2f(Qg[d]), bf2f(Qg[D + d]), bf2f(Qg[2 * D + d]), bf2f(Qg[3 * D + d])};
        kws[d] = (f32x4){g3 * bf2f(Kg[d]), g2 * bf2f(Kg[D + d]), g * bf2f(Kg[2 * D + d]), bf2f(Kg[3 * D + d])}; }
#pragma unroll
    for (int e = 0; e < 2; ++e) { const int id = 2 * wid + e, i = id >> 2, j = id & 3;
        const u32x2 qw = *(const u32x2*)(Qg + (size_t)i * D + lane * 4), kw = *(const u32x2*)(Kg + (size_t)j * D + lane * 4);
        float d = (bflo(qw.x) * bflo(kw.x) + bfhi(qw.x) * bfhi(kw.x)) + (bflo(qw.y) * bflo(kw.y) + bfhi(qw.y) * bfhi(kw.y));
        d = wave_sum(d); if (lane == 0) asc[id] = d; }
    __syncthreads();
    const int v4 = tid & 127, rg = tid >> 7;
    f32x4 vj[4];
#pragma unroll
    for (int j = 0; j < 4; ++j) { const u32x2 w = *(const u32x2*)(Vg + (size_t)j * VD + v4 * 4); vj[j] = (f32x4){bflo(w.x), bfhi(w.x), bflo(w.y), bfhi(w.y)}; }
    f32x4 oa[4];
#pragma unroll
    for (int i = 0; i < 4; ++i) oa[i] = (f32x4){0.f, 0.f, 0.f, 0.f};
    const float* S0 = p.in[3] + ((size_t)(s * 4 + h) * 256) * 512 + v4 * 4;
    float* S1 = p.out + OUT_RETS + ((size_t)(s * 4 + h) * 256) * 512 + v4 * 4;
#pragma unroll 8
    for (int it = 0; it < 64; ++it) { const int d = it * 4 + rg;
        const f32x4 s0 = __builtin_nontemporal_load((const f32x4*)(S0 + (size_t)d * 512));
        const f32x4 q4 = qs[d], k4 = kws[d];
        oa[0] += q4[0] * s0; oa[1] += q4[1] * s0; oa[2] += q4[2] * s0; oa[3] += q4[3] * s0;
        const f32x4 sn = g4 * s0 + ((k4[0] * vj[0] + k4[1] * vj[1]) + (k4[2] * vj[2] + k4[3] * vj[3]));
        __builtin_nontemporal_store(sn, (f32x4*)(S1 + (size_t)d * 512)); }
#pragma unroll
    for (int i = 0; i < 4; ++i) *(LAS f32x4*)(red + ((rg * 4 + i) * 512 + v4 * 4)) = oa[i];
    __syncthreads();
    { const int i = rg;
        f32x4 cr = (f32x4){0.f, 0.f, 0.f, 0.f};
#pragma unroll
        for (int r = 0; r < 4; ++r) cr += *(LAS f32x4*)(red + ((r * 4 + i) * 512 + v4 * 4));
        const float cwi = i == 0 ? g : (i == 1 ? g2 : (i == 2 ? g3 : g4));
        f32x4 o = cr * cwi;
        float dec = 1.f;
        for (int j = i; j >= 0; --j) { o += (asc[i * 4 + j] * dec) * vj[j]; dec *= g; }
        u32x2 w; w.x = cvt_pk_bf16(o[0], o[1]); w.y = cvt_pk_bf16(o[2], o[3]);
        *(u32x2*)(Og + (size_t)i * VD + v4 * 4) = w; }
}


constexpr int LDS_FQ = LDS_RET_END, LDS_FK = LDS_FQ + 4096, LDS_FA = LDS_FK + 4096;
static_assert(LDS_FA + 64 <= LDS_XB_ST, "fused retention LDS");
__device__ __forceinline__ void retention_fused(const Params& p, LAS unsigned char* lds, int unit) {
    const int tid = threadIdx.x, lane = tid & 63, wid = __builtin_amdgcn_readfirstlane(tid >> 6), fr = lane & 15, fq = lane >> 4;
    const int b = unit >> 5, h = (unit >> 3) & 3, vb = unit & 7;
    unsigned char* ws = p.ws;
    const bf16_t* Qg = (const bf16_t*)(ws + WS_Q) + (size_t)b * SEQ * D + h * 256;
    const bf16_t* Kg = (const bf16_t*)(ws + WS_K) + (size_t)b * SEQ * D + h * 256;
    const bf16_t* Vg = (const bf16_t*)(ws + WS_V) + (size_t)b * SEQ * VD + h * 512 + vb * 64;
    bf16_t* Og = (bf16_t*)(ws + WS_O) + (size_t)b * SEQ * VD + h * 512 + vb * 64;
    const float log2g = __log2f(1.0f - exp2f(-5.0f - (float)h));
    const float gC = exp2f(128.0f * log2g);
    f32x4 S[2][4];
#pragma unroll
    for (int mt = 0; mt < 2; ++mt)
#pragma unroll
        for (int nt = 0; nt < 4; ++nt) S[mt][nt] = (f32x4){0.f, 0.f, 0.f, 0.f};
    LAS unsigned char* Ks = lds + LDS_KS; LAS unsigned char* Vs = lds + LDS_VS; LAS unsigned char* Vw = lds + LDS_VW; LAS unsigned char* St = lds + LDS_ST;
    LAS f32x4* qs = (LAS f32x4*)(lds + LDS_FQ); LAS f32x4* kws = (LAS f32x4*)(lds + LDS_FK); LAS float* asc = (LAS float*)(lds + LDS_FA); LAS float* red = (LAS float*)(lds + 0);
    const int v4 = tid & 127, rg = tid >> 7;
    u32x2 vjp[4]; f32x4 oa[4];
    const float* S0 = nullptr; float* S1 = nullptr; bf16_t* Ogs = nullptr;
    float sg = 0.f, sg2 = 0.f, sg3 = 0.f, sg4 = 0.f;
#pragma unroll
    for (int i = 0; i < 4; ++i) { vjp[i] = (u32x2){0u, 0u}; oa[i] = (f32x4){0.f, 0.f, 0.f, 0.f}; }
    for (int c = 0; c < 16; ++c) {
        __syncthreads();
        if ((c & 7) == 0) {
            const int su = unit + (c >> 3) * 256, ss = su >> 2, sh = su & 3, t0 = TP + ss * 4;
            const bf16_t* Qs = (const bf16_t*)(ws + WS_Q) + (size_t)t0 * D + sh * 256;
            const bf16_t* Kq = (const bf16_t*)(ws + WS_K) + (size_t)t0 * D + sh * 256;
            const bf16_t* Vq = (const bf16_t*)(ws + WS_V) + (size_t)t0 * VD + sh * 512;
            Ogs = (bf16_t*)(ws + WS_O) + (size_t)t0 * VD + sh * 512;
            sg = 1.0f - exp2f(-5.0f - (float)sh); sg2 = sg * sg; sg3 = sg2 * sg; sg4 = sg2 * sg2;
            if (tid < 256) { const int d = tid;
                qs[d] = (f32x4){bf2f(Qs[d]), bf2f(Qs[D + d]), bf2f(Qs[2 * D + d]), bf2f(Qs[3 * D + d])};
                kws[d] = (f32x4){sg3 * bf2f(Kq[d]), sg2 * bf2f(Kq[D + d]), sg * bf2f(Kq[2 * D + d]), bf2f(Kq[3 * D + d])}; }
#pragma unroll
            for (int e = 0; e < 2; ++e) { const int id = 2 * wid + e, i = id >> 2, j = id & 3;
                const u32x2 qw = *(const u32x2*)(Qs + (size_t)i * D + lane * 4), kw = *(const u32x2*)(Kq + (size_t)j * D + lane * 4);
                float dd = (bflo(qw.x) * bflo(kw.x) + bfhi(qw.x) * bfhi(kw.x)) + (bflo(qw.y) * bflo(kw.y) + bfhi(qw.y) * bfhi(kw.y));
                dd = wave_sum(dd); if (lane == 0) asc[id] = dd; }
#pragma unroll
            for (int j = 0; j < 4; ++j) { vjp[j] = *(const u32x2*)(Vq + (size_t)j * VD + v4 * 4); oa[j] = (f32x4){0.f, 0.f, 0.f, 0.f}; }
            S0 = p.in[3] + ((size_t)(ss * 4 + sh) * 256) * 512 + v4 * 4;
            S1 = p.out + OUT_RETS + ((size_t)(ss * 4 + sh) * 256) * 512 + v4 * 4;
        }
#pragma unroll
        for (int mt = 0; mt < 2; ++mt)
#pragma unroll
            for (int nt = 0; nt < 4; ++nt) { u32x2 w; w.x = cvt_pk_bf16(S[mt][nt][0], S[mt][nt][1]); w.y = cvt_pk_bf16(S[mt][nt][2], S[mt][nt][3]);
                *(LAS u32x2*)(St + (nt * 16 + fr) * ST_STRIDE + (32 * wid + 16 * mt + fq * 4) * 2) = w; }
#pragma unroll
        for (int i = 0; i < 8; ++i) { const int id = tid + i * NTHREADS, row = id >> 5, cc = id & 31; *(LAS u32x4*)(Ks + row * KS_STRIDE + cc * 16) = *(const u32x4*)(Kg + (size_t)(c * 128 + row) * D + cc * 8); }
#pragma unroll
        for (int i = 0; i < 2; ++i) { const int id = tid + i * NTHREADS, row = id >> 3, cc = id & 7;
            const u32x4 v = *(const u32x4*)(Vg + (size_t)(c * 128 + row) * VD + cc * 8);
            *(LAS u32x4*)(Vs + row * VS_STRIDE + cc * 16) = v;
            const float sw = exp2f((float)(127 - row) * log2g);
            u32x4 w; w.x = cvt_pk_bf16(bflo(v.x) * sw, bfhi(v.x) * sw); w.y = cvt_pk_bf16(bflo(v.y) * sw, bfhi(v.y) * sw); w.z = cvt_pk_bf16(bflo(v.z) * sw, bfhi(v.z) * sw); w.w = cvt_pk_bf16(bflo(v.w) * sw, bfhi(v.w) * sw);
            *(LAS u32x4*)(Vw + row * VS_STRIDE + cc * 16) = w; }
        bf16x8 qf[8];
#pragma unroll
        for (int ks = 0; ks < 8; ++ks) qf[ks] = *(const bf16x8*)(Qg + (size_t)(c * 128 + 16 * wid + fr) * D + ks * 32 + fq * 8);
        __syncthreads();
        f32x4 s0v[4];
        const int dbase = (c & 7) * 32 + rg;
#define SAMPLE_ISSUE(hb) do { _Pragma("unroll") for (int i = 0; i < 4; ++i) s0v[i] = __builtin_nontemporal_load((const f32x4*)(S0 + (size_t)(dbase + 4 * ((hb) * 4 + i)) * 512)); } while (0)
#define SAMPLE_CONSUME(hb) do { const f32x4 vj0 = (f32x4){bflo(vjp[0].x), bfhi(vjp[0].x), bflo(vjp[0].y), bfhi(vjp[0].y)}, vj1 = (f32x4){bflo(vjp[1].x), bfhi(vjp[1].x), bflo(vjp[1].y), bfhi(vjp[1].y)}, \
            vj2 = (f32x4){bflo(vjp[2].x), bfhi(vjp[2].x), bflo(vjp[2].y), bfhi(vjp[2].y)}, vj3 = (f32x4){bflo(vjp[3].x), bfhi(vjp[3].x), bflo(vjp[3].y), bfhi(vjp[3].y)}; \
        _Pragma("unroll") for (int i = 0; i < 4; ++i) { const int d = dbase + 4 * ((hb) * 4 + i); \
            const f32x4 q4 = qs[d], k4 = kws[d], s0 = s0v[i]; \
            oa[0] += q4[0] * s0; oa[1] += q4[1] * s0; oa[2] += q4[2] * s0; oa[3] += q4[3] * s0; \
            const f32x4 sn = sg4 * s0 + ((k4[0] * vj0 + k4[1] * vj1) + (k4[2] * vj2 + k4[3] * vj3)); \
            __builtin_nontemporal_store(sn, (f32x4*)(S1 + (size_t)d * 512)); } } while (0)
        SAMPLE_ISSUE(0);
        f32x4 o[4];
#pragma unroll
        for (int nt = 0; nt < 4; ++nt) {
            o[nt] = (f32x4){0.f, 0.f, 0.f, 0.f};
#pragma unroll
            for (int ks = 0; ks < 8; ++ks) { const bf16x8 sf = *(const LAS bf16x8*)(St + (nt * 16 + fr) * ST_STRIDE + ks * 64 + fq * 16);
                o[nt] = __builtin_amdgcn_mfma_f32_16x16x32_bf16(qf[ks], sf, o[nt], 0, 0, 0); }
#pragma unroll
            for (int r = 0; r < 4; ++r) o[nt][r] *= exp2f((float)(16 * wid + fq * 4 + r + 1) * log2g);
        }
#pragma unroll 1
        for (int a = 0; 2 * a <= wid; ++a) {
            {
                f32x4 sc[2];
#pragma unroll
                for (int t = 0; t < 2; ++t) { const int jt = 2 * a + t;
                    sc[t] = (f32x4){0.f, 0.f, 0.f, 0.f};
                    if (jt <= wid) {
#pragma unroll
                        for (int ks = 0; ks < 8; ++ks) { const bf16x8 kf = *(const LAS bf16x8*)(Ks + (jt * 16 + fr) * KS_STRIDE + ks * 64 + fq * 16);
                            sc[t] = __builtin_amdgcn_mfma_f32_16x16x32_bf16(kf, qf[ks], sc[t], 0, 0, 0); }
#pragma unroll
                        for (int r = 0; r < 4; ++r) { const int dij = 16 * (wid - jt) + fr - fq * 4 - r;
                            sc[t][r] = dij >= 0 ? sc[t][r] * exp2f((float)dij * log2g) : 0.f; }
                    } }
                bf16x8 pa; { const u32x4 w = (u32x4){cvt_pk_bf16(sc[0][0], sc[0][1]), cvt_pk_bf16(sc[0][2], sc[0][3]), cvt_pk_bf16(sc[1][0], sc[1][1]), cvt_pk_bf16(sc[1][2], sc[1][3])}; pa = __builtin_bit_cast(bf16x8, w); }
#pragma unroll
                for (int nt = 0; nt < 4; ++nt) {
                    LAS const unsigned char* a0 = Vs + (32 * a + fq * 4 + (fr >> 2)) * VS_STRIDE + (nt * 16 + 4 * (fr & 3)) * 2;
                    const bf16x8 vf = tr_read2(a0, a0 + 16 * VS_STRIDE);
                    o[nt] = __builtin_amdgcn_mfma_f32_16x16x32_bf16(pa, vf, o[nt], 0, 0, 0); }
            }
        }
        SAMPLE_CONSUME(0);
        SAMPLE_ISSUE(1);
#pragma unroll
        for (int nt = 0; nt < 4; ++nt)
#pragma unroll
            for (int r = 0; r < 4; ++r) Og[(size_t)(c * 128 + 16 * wid + fq * 4 + r) * VD + nt * 16 + fr] = (bf16_t)(cvt_pk_bf16(o[nt][r], 0.f) & 0xffffu);
#pragma unroll
        for (int mt = 0; mt < 2; ++mt)
#pragma unroll
            for (int nt = 0; nt < 4; ++nt) S[mt][nt] = S[mt][nt] * gC;
#pragma unroll
        for (int ks = 0; ks < 4; ++ks) {
            bf16x8 af[2];
#pragma unroll
            for (int mt = 0; mt < 2; ++mt) { LAS const unsigned char* a0 = Ks + (ks * 32 + fq * 8 + (fr >> 2)) * KS_STRIDE + (32 * wid + 16 * mt + 4 * (fr & 3)) * 2;
                af[mt] = tr_read2(a0, a0 + 4 * KS_STRIDE); }
#pragma unroll
            for (int nt = 0; nt < 4; ++nt) { LAS const unsigned char* b0 = Vw + (ks * 32 + fq * 8 + (fr >> 2)) * VS_STRIDE + (nt * 16 + 4 * (fr & 3)) * 2;
                const bf16x8 bfr = tr_read2(b0, b0 + 4 * VS_STRIDE);
#pragma unroll
                for (int mt = 0; mt < 2; ++mt) S[mt][nt] = __builtin_amdgcn_mfma_f32_16x16x32_bf16(af[mt], bfr, S[mt][nt], 0, 0, 0); }
        }
        SAMPLE_CONSUME(1);
        if ((c & 7) == 7) {
            __syncthreads();
#pragma unroll
            for (int i = 0; i < 4; ++i) *(LAS f32x4*)(red + ((rg * 4 + i) * 512 + v4 * 4)) = oa[i];
            __syncthreads();
            const int i = rg;
            f32x4 cr = (f32x4){0.f, 0.f, 0.f, 0.f};
#pragma unroll
            for (int r = 0; r < 4; ++r) cr += *(LAS f32x4*)(red + ((r * 4 + i) * 512 + v4 * 4));
            const float cwi = i == 0 ? sg : (i == 1 ? sg2 : (i == 2 ? sg3 : sg4));
            f32x4 oo = cr * cwi;
            const f32x4 vsel0 = (f32x4){bflo(vjp[0].x), bfhi(vjp[0].x), bflo(vjp[0].y), bfhi(vjp[0].y)}, vsel1 = (f32x4){bflo(vjp[1].x), bfhi(vjp[1].x), bflo(vjp[1].y), bfhi(vjp[1].y)}, vsel2 = (f32x4){bflo(vjp[2].x), bfhi(vjp[2].x), bflo(vjp[2].y), bfhi(vjp[2].y)}, vsel3 = (f32x4){bflo(vjp[3].x), bfhi(vjp[3].x), bflo(vjp[3].y), bfhi(vjp[3].y)};
            if (i >= 0) oo += (asc[i * 4 + 0] * (i == 0 ? 1.f : (i == 1 ? sg : (i == 2 ? sg2 : sg3)))) * vsel0;
            if (i >= 1) oo += (asc[i * 4 + 1] * (i == 1 ? 1.f : (i == 2 ? sg : sg2))) * vsel1;
            if (i >= 2) oo += (asc[i * 4 + 2] * (i == 2 ? 1.f : sg)) * vsel2;
            if (i >= 3) oo += asc[i * 4 + 3] * vsel3;
            u32x2 w; w.x = cvt_pk_bf16(oo[0], oo[1]); w.y = cvt_pk_bf16(oo[2], oo[3]);
            *(u32x2*)(Ogs + (size_t)i * VD + v4 * 4) = w;
        }
    }
#undef SAMPLE_ISSUE
#undef SAMPLE_CONSUME
    float* So = p.out + OUT_RETP + ((size_t)(b * 4 + h) * 256) * 512 + vb * 64;
#pragma unroll
    for (int mt = 0; mt < 2; ++mt)
#pragma unroll
        for (int nt = 0; nt < 4; ++nt)
#pragma unroll
            for (int r = 0; r < 4; ++r) So[(size_t)(32 * wid + 16 * mt + fq * 4 + r) * 512 + nt * 16 + fr] = S[mt][nt][r];
}

__device__ __forceinline__ void phase_retention(const Params& p, LAS unsigned char* lds, int vcu, int G) {
    if (G == 256) { retention_fused(p, lds, vcu); __syncthreads(); return; }
    for (int unit = vcu; unit < 256; unit += G) retention_prompt_unit(p, lds, unit);
    for (int unit = vcu; unit < 512; unit += G) retention_sample_unit(p, lds, unit);
    __syncthreads();
}

__device__ __forceinline__ void phase_gnorm(const Params& p, int vcu, int G) {
    const int tid = threadIdx.x, lane = tid & 63, wave = tid >> 6;
    unsigned char* ws = p.ws;
    const bf16_t* O = (const bf16_t*)(ws + WS_O); const bf16_t* Gt = (const bf16_t*)(ws + WS_G); bf16_t* A8 = (bf16_t*)(ws + WS_A8);
    for (int t0 = (vcu * NWAVES + wave) * 2; t0 < T; t0 += G * NWAVES * 2) {
        u32x4 xo[8], xg[8];
#pragma unroll
        for (int i = 0; i < 8; ++i) { const size_t off = (size_t)(t0 + (i >> 2)) * VD + (i & 3) * 512 + lane * 8; xo[i] = __builtin_nontemporal_load((const u32x4*)(O + off)); xg[i] = __builtin_nontemporal_load((const u32x4*)(Gt + off)); }
#pragma unroll
        for (int i = 0; i < 8; ++i) { const size_t off = (size_t)(t0 + (i >> 2)) * VD + (i & 3) * 512 + lane * 8;
            float x[8], g[8]; unpack8(xo[i], x); unpack8(xg[i], g);
            const float s1 = ((x[0] + x[1]) + (x[2] + x[3])) + ((x[4] + x[5]) + (x[6] + x[7]));
            const float mu = wave_sum(s1) * (1.0f / 512.0f);
            float q = 0.f;
#pragma unroll
            for (int e = 0; e < 8; ++e) { x[e] -= mu; q += x[e] * x[e]; }
            const float rstd = rsqrtf(wave_sum(q) * (1.0f / 512.0f) + GN_EPS);
            f32x4 o[2];
#pragma unroll
            for (int e = 0; e < 8; ++e) o[e >> 2][e & 3] = g[e] * (x[e] * rstd);
            __builtin_nontemporal_store(pack8(o[0], o[1]), (u32x4*)(A8 + off)); }
    }
}

template <int NSLICE, bool FIRST> __device__ __forceinline__ void sample_finalize(const Params& p, int vcu, int G) {
    const int tid = threadIdx.x, lane = tid & 63, wave = tid >> 6;
    unsigned char* ws = p.ws;
    bf16_t* xb = (bf16_t*)(ws + WS_XB); float* part = (float*)(ws + WS_PART); const float* split = (const float*)(ws + WS_SPLIT);
    for (int row = TP + vcu * NWAVES + wave; row < T; row += G * NWAVES) {
        float ss = 0.f;
#pragma unroll
        for (int j = 0; j < 2; ++j) { const int col = j * 512 + lane * 8;
            f32x4 v0, v1;
            if (FIRST) { const float* xs = p.in[1] + (size_t)(row - TP) * D + col; v0 = *(const f32x4*)xs; v1 = *(const f32x4*)(xs + 4); }
            else { const u32x4 w = *(const u32x4*)(xb + (size_t)row * D + col); v0 = (f32x4){bflo(w.x), bfhi(w.x), bflo(w.y), bfhi(w.y)}; v1 = (f32x4){bflo(w.z), bfhi(w.z), bflo(w.w), bfhi(w.w)}; }
#pragma unroll
            for (int sl = 0; sl < NSLICE; ++sl) { const float* sp = split + ((size_t)sl * TS + (row - TP)) * D + col; v0 += *(const f32x4*)sp; v1 += *(const f32x4*)(sp + 4); }
            *(u32x4*)(xb + (size_t)row * D + col) = pack8(v0, v1);
            ss += ((v0[0] * v0[0] + v0[1] * v0[1]) + (v0[2] * v0[2] + v0[3] * v0[3])) + ((v1[0] * v1[0] + v1[1] * v1[1]) + (v1[2] * v1[2] + v1[3] * v1[3])); }
        ss = wave_sum(ss);
        if (lane < 16) part[(size_t)row * 16 + lane] = (lane == 0) ? ss : 0.f;
    }
}
__device__ __forceinline__ void phase_final(const Params& p, int vcu, int G) {
    const int tid = threadIdx.x, lane = tid & 63, wave = tid >> 6;
    unsigned char* ws = p.ws;
    const float* gn = p.in[15]; const float* split = (const float*)(ws + WS_SPLIT); const bf16_t* xbq = (const bf16_t*)(ws + WS_XB);
    float* y = p.out + OUT_Y;
    f32x4 gg[4];
#pragma unroll
    for (int j = 0; j < 4; ++j) gg[j] = *(const f32x4*)(gn + j * 256 + lane * 4);
    for (int r0 = (vcu * NWAVES + wave) * 2; r0 < T; r0 += G * NWAVES * 2) {
        f32x4 v[2][4];
#pragma unroll
        for (int k = 0; k < 2; ++k)
#pragma unroll
            for (int j = 0; j < 4; ++j) { const u32x2 w = __builtin_nontemporal_load((const u32x2*)(xbq + (size_t)(r0 + k) * D + j * 256 + lane * 4)); v[k][j] = (f32x4){bflo(w.x), bfhi(w.x), bflo(w.y), bfhi(w.y)}; }
        if (r0 >= TP) {
#pragma unroll
            for (int k = 0; k < 2; ++k)
#pragma unroll
                for (int j = 0; j < 4; ++j)
#pragma unroll
                    for (int sl = 0; sl < 11; ++sl) v[k][j] += *(const f32x4*)(split + ((size_t)sl * TS + (r0 + k - TP)) * D + j * 256 + lane * 4);
        }
#pragma unroll
        for (int k = 0; k < 2; ++k) { float ss = 0.f;
#pragma unroll
            for (int j = 0; j < 4; ++j) ss += (v[k][j][0] * v[k][j][0] + v[k][j][1] * v[k][j][1]) + (v[k][j][2] * v[k][j][2] + v[k][j][3] * v[k][j][3]);
            const float rs = rsqrtf(wave_sum(ss) * (1.0f / D) + RMS_EPS);
#pragma unroll
            for (int j = 0; j < 4; ++j) __builtin_nontemporal_store(v[k][j] * rs * gg[j], (f32x4*)(y + (size_t)(r0 + k) * D + j * 256 + lane * 4)); }
    }
}

constexpr int NPHASES = 13;
__global__ void __launch_bounds__(NTHREADS, 2) mega_fwd(Params p) {
    extern __shared__ __attribute__((aligned(16))) unsigned char lds_raw[];
    LAS unsigned char* lds = (LAS unsigned char*)lds_raw;
    cg::grid_group grid = cg::this_grid();
    const int G = gridDim.x, bx = blockIdx.x;
    const int vcu = (G % 8 == 0) ? (bx % 8) * (G / 8) + bx / 8 : bx;
    unsigned char* ws = p.ws;
    const int lo = p.ph_lo, hi = p.ph_hi;
#define IN(k) (lo <= (k) && (k) < hi)
#define SEAM(k) do { if (IN(k) && IN((k) + 1)) { if (lo < 0) grid.sync(); else xcd_barrier(bar); } } while (0)
    if (threadIdx.x < 2) ((LAS unsigned*)(lds + LDS_XB_ST))[threadIdx.x] = 0u;
    __syncthreads();
    XcdBarrier bar; bar.bar = (unsigned*)(ws + WS_BAR); bar.x = 0; bar.st = nullptr;
    if (hi - lo > 1) bar = xcd_barrier_post((unsigned*)(ws + WS_BAR), (volatile LAS unsigned*)(lds + LDS_XB_ST));
    const float* part = (const float*)(ws + WS_PART);
    bf16_t* xb = (bf16_t*)(ws + WS_XB); float* xres = (float*)(ws + WS_XRES);

    if (IN(0)) { phase_prologue(p, lds, vcu, G); } SEAM(0);
    if (IN(1)) {
        pg8::Gemm g{xb, (const bf16_t*)(ws + WS_WCIN), T, 3072, 1024}; pg8::StaticOrder S; S.init(T, 3072, G, bx, g.K);
        EpiConvIn E{part, (bf16_t*)(ws + WS_BB), (bf16_t*)(ws + WS_UB), p.out + OUT_CONVP, p.out + OUT_CONVS};
        pg8::gemm_phase<EpiConvIn, pg8::StaticOrder, true, true>(lds, g, S, E);
        idle_slot_transposes(p, lds, 1, S.nwg, G, bx);
    } SEAM(1);
    if (IN(2)) { phase_conv(p, vcu, G); } SEAM(2);
    if (IN(3)) {
        pg8::Gemm g{(const bf16_t*)(ws + WS_A2), (const bf16_t*)(ws + WS_WCOUT), T, 1024, 1024}; pg8::SplitOrder S; S.init(TP, 1024, G, bx, g.K);
        EpiResid<1> E{p.in[0], p.in[1], xres, xb, (float*)(ws + WS_PART), (float*)(ws + WS_SPLIT)};
        pg8::gemm_phase<EpiResid<1>, pg8::SplitOrder, true, true>(lds, g, S, E);
    } SEAM(3);
    if (IN(4)) {
        sample_finalize<4, false>(p, vcu, G); xcd_barrier(bar);
        pg8::Gemm g{xb, (const bf16_t*)(ws + WS_WGU0), T, 5632, 1024}; pg8::StaticOrder S; S.init(T, 5632, G, bx, g.K);
        EpiSwiGLU E{part, (bf16_t*)(ws + WS_HFF)};
        pg8::gemm_phase<EpiSwiGLU, pg8::StaticOrder, true, true>(lds, g, S, E);
        idle_slot_transposes(p, lds, 2, S.nwg, G, bx);
    } SEAM(4);
    if (IN(5)) {
        pg8::Gemm g{(const bf16_t*)(ws + WS_HFF), (const bf16_t*)(ws + WS_WD0), T, 1024, DFF}; pg8::SplitOrder S; S.init(TP, 1024, G, bx, g.K);
        EpiResid<1> E{nullptr, nullptr, xres, xb, (float*)(ws + WS_PART), (float*)(ws + WS_SPLIT)};
        pg8::gemm_phase<EpiResid<1>, pg8::SplitOrder, true, true>(lds, g, S, E);
    } SEAM(5);
    if (IN(6)) {
        sample_finalize<11, false>(p, vcu, G); xcd_barrier(bar);
        pg8::Gemm g{xb, (const bf16_t*)(ws + WS_WRIN), T, RIN, 1024}; pg8::StaticOrder S; S.init(T, RIN, G, bx, g.K);
        EpiRetIn E{part, (const float*)(ws + WS_ROPE), (bf16_t*)(ws + WS_Q), (bf16_t*)(ws + WS_K), (bf16_t*)(ws + WS_V), (bf16_t*)(ws + WS_G)};
        pg8::gemm_phase<EpiRetIn, pg8::StaticOrder, true, true>(lds, g, S, E);
        idle_slot_transposes(p, lds, 3, S.nwg, G, bx);
    } SEAM(6);
    if (IN(7)) { phase_retention(p, lds, vcu, G); } SEAM(7);
    if (IN(8)) { phase_gnorm(p, vcu, G); } SEAM(8);
    if (IN(9)) {
        pg8::Gemm g{(const bf16_t*)(ws + WS_A8), (const bf16_t*)(ws + WS_WROUT), T, 1024, VD}; pg8::SplitOrder S; S.init(TP, 1024, G, bx, g.K);
        EpiResid<1> E{nullptr, nullptr, xres, xb, (float*)(ws + WS_PART), (float*)(ws + WS_SPLIT)};
        pg8::gemm_phase<EpiResid<1>, pg8::SplitOrder, true, true>(lds, g, S, E);
    } SEAM(9);
    if (IN(10)) {
        sample_finalize<8, false>(p, vcu, G); xcd_barrier(bar);
        pg8::Gemm g{xb, (const bf16_t*)(ws + WS_WGU1), T, 5632, 1024}; pg8::StaticOrder S; S.init(T, 5632, G, bx, g.K);
        EpiSwiGLU E{part, (bf16_t*)(ws + WS_HFF)};
        pg8::gemm_phase<EpiSwiGLU, pg8::StaticOrder, true, true>(lds, g, S, E);
    } SEAM(10);
    if (IN(11)) {
        pg8::Gemm g{(const bf16_t*)(ws + WS_HFF), (const bf16_t*)(ws + WS_WD1), T, 1024, DFF}; pg8::SplitOrder S; S.init(TP, 1024, G, bx, g.K);
        EpiResid<2> E{nullptr, nullptr, xres, xb, (float*)(ws + WS_PART), (float*)(ws + WS_SPLIT)};
        pg8::gemm_phase<EpiResid<2>, pg8::SplitOrder, true, true>(lds, g, S, E);
    } SEAM(11);
    if (IN(12)) { phase_final(p, vcu, G); }
#undef IN
#undef SEAM
}

extern "C" void kernel_launch(void* const* d_in, const int* in_sizes, int n_in, void* d_out, int out_size, void* d_ws, size_t ws_size, hipStream_t stream) {
    static int grid = 0;
    if (grid == 0) {
        if (n_in != 16 || (size_t)out_size != OUT_END || ws_size < WS_END) { fprintf(stderr, "kernel_launch: unexpected shapes: n_in %d out %d ws %zu (need %zu)\n", n_in, out_size, ws_size, (size_t)WS_END); grid = -1; return; }
        int dev = 0, cus = 0, per_cu = 0;
        (void)hipGetDevice(&dev); (void)hipDeviceGetAttribute(&cus, hipDeviceAttributeMultiprocessorCount, dev);
        if (hipFuncSetAttribute((const void*)mega_fwd, hipFuncAttributeMaxDynamicSharedMemorySize, LDS_BYTES) != hipSuccess) { fprintf(stderr, "kernel_launch: hipFuncSetAttribute failed\n"); grid = -1; return; }
        if (hipOccupancyMaxActiveBlocksPerMultiprocessor(&per_cu, (const void*)mega_fwd, NTHREADS, LDS_BYTES) != hipSuccess || per_cu < 1) { fprintf(stderr, "kernel_launch: occupancy query failed (%d)\n", per_cu); (void)hipGetLastError(); per_cu = 1; }
        grid = cus * per_cu;
        if (grid % 8 != 0 || grid <= 0) grid = cus;
    }
    if (grid < 0) return;
    if (hipMemsetAsync((unsigned char*)d_ws + WS_BAR, 0, BAR_BYTES, stream) != hipSuccess) { fprintf(stderr, "memset failed\n"); return; }
    Params p{};
    for (int i = 0; i < 16; ++i) p.in[i] = (const float*)d_in[i];
    p.out = (float*)d_out; p.ws = (unsigned char*)d_ws;
#if MK_N_LAUNCHES == 1
    p.ph_lo = 0; p.ph_hi = NPHASES;
    void* args[] = {&p};
    hipError_t e = hipLaunchCooperativeKernel((const void*)mega_fwd, dim3(grid), dim3(NTHREADS), args, LDS_BYTES, stream);
    if (e != hipSuccess) fprintf(stderr, "cooperative launch failed: %s (grid %d)\n", hipGetErrorString(e), grid);
#else
    for (int ph = 0; ph < NPHASES; ++ph) { p.ph_lo = ph; p.ph_hi = ph + 1; hipLaunchKernelGGL(mega_fwd, dim3(grid), dim3(NTHREADS), LDS_BYTES, stream, p); }
#endif
}
```
